# Optimizing an MI355X kernel written in HIP

```python
import jax
import jax.numpy as jnp
from jax import lax
import numpy as np

D_MODEL = 1024
BATCH = 2
SEQ = 16384
DEPTH = 4
DEC_BATCH = 16
DEC_SEQ = 64
PAST_LEN = 4096

CHUNK = 64
N_EVEN = (DEPTH + 1) // 2
N_ODD = DEPTH // 2
N_SUB = 3
EPS = 1e-6
NEG = -1e30

MLA_HEADS = 8
MLA_NOPE = 64
MLA_ROPE = 32
MLA_V = 64
MLA_Q_LORA = 768
MLA_KV_LORA = 256
MLA_QBLOCK = 128
MLA_SCALE = (MLA_NOPE + MLA_ROPE) ** -0.5
ROPE_BASE = 10000.0
MLA_COLS = MLA_Q_LORA + MLA_KV_LORA + MLA_ROPE

RW_HEADS = 8
RW_N = 64
RW_C = RW_HEADS * RW_N
RW_DECAY_LORA = 64
RW_A_LORA = 64
RW_G_LORA = 128
RW_GN_EPS = 64e-5
RW_SPLITS = [RW_C, RW_C + RW_DECAY_LORA, 2 * RW_C + RW_DECAY_LORA, 3 * RW_C + RW_DECAY_LORA,
             3 * RW_C + RW_DECAY_LORA + RW_A_LORA]
RW_COLS = 3 * RW_C + RW_DECAY_LORA + RW_A_LORA + RW_G_LORA
EVEN_IN = MLA_COLS + RW_COLS
EVEN_MIX = MLA_HEADS * MLA_V + RW_C

SW_HEADS = 16
SW_KV_HEADS = 4
SW_GROUP = SW_HEADS // SW_KV_HEADS
SW_HD = 64
WINDOW = 128
WIN_CHUNKS = WINDOW // CHUNK
ODD_MIX = SW_HEADS * SW_HD
ODD_IN = ODD_MIX + 2 * SW_KV_HEADS * SW_HD

D_FF = 2816

kernel_name = 'hybrid_streaming_mla_rwkv7_swa_step'


def rms_norm(x, g):
    xf = x.astype(jnp.float32)
    y = xf * lax.rsqrt(jnp.mean(xf * xf, axis=-1, keepdims=True) + EPS)
    return (y * g.astype(jnp.float32)).astype(x.dtype)


def modulate(x, g, shift, scale):
    return rms_norm(x, g) * (1 + scale[:, None, :]) + shift[:, None, :]


def swiglu(h, w_in, w_out):
    gate, up = jnp.split(h @ w_in, 2, axis=-1)
    return (jax.nn.silu(gate) * up) @ w_out


def rope(x, pos):
    half = x.shape[-1] // 2
    freqs = ROPE_BASE ** (-jnp.arange(half, dtype=jnp.float32) / half)
    ang = pos[:, None] * freqs[None, :]
    ang = ang.reshape((ang.shape[0],) + (1,) * (x.ndim - 3) + (half,))
    cos, sin = jnp.cos(ang), jnp.sin(ang)
    xf = x.astype(jnp.float32)
    x1, x2 = xf[..., :half], xf[..., half:]
    return jnp.concatenate([x1 * cos - x2 * sin, x1 * sin + x2 * cos], axis=-1).astype(x.dtype)


def mla_expand(ckv, w_ukv):
    kv = jnp.einsum('bsl,lhe->bshe', ckv, w_ukv)
    return kv[..., :MLA_NOPE], kv[..., MLA_NOPE:]


def mla_attend(qn, qr, kn, kr, v, mask):
    s = (jnp.einsum('bqhd,bshd->bhqs', qn, kn) + jnp.einsum('bqhr,bsr->bhqs', qr, kr)).astype(jnp.float32) * MLA_SCALE
    if mask is not None:
        s = jnp.where(mask, s, NEG)
    p = jax.nn.softmax(s, axis=-1).astype(v.dtype)
    return jnp.einsum('bhqs,bshd->bqhd', p, v)


def mla_prompt(qn, qr, kn, kr, v):
    B, T = qn.shape[0], qn.shape[1]
    nb = T // MLA_QBLOCK
    key_chunk = jnp.arange(T) // CHUNK

    def to_blocks(t):
        return jnp.moveaxis(t.reshape((B, nb, MLA_QBLOCK) + t.shape[2:]), 1, 0)

    def block(args):
        bi, qn_b, qr_b = args
        q_chunk = (bi * MLA_QBLOCK + jnp.arange(MLA_QBLOCK)) // CHUNK
        mask = key_chunk[None, :] <= q_chunk[:, None]
        return mla_attend(qn_b, qr_b, kn, kr, v, mask)

    o = lax.map(block, (jnp.arange(nb), to_blocks(qn), to_blocks(qr)))
    return jnp.moveaxis(o, 0, 1).reshape(B, T, MLA_HEADS, MLA_V)


def wkv7_scan(r, w, k, v, a, b, s0):
    def step(S, inp):
        r_t, w_t, k_t, v_t, a_t, b_t = inp
        sa = jnp.einsum('bhij,bhj->bhi', S, a_t)
        S = S * w_t[:, :, None, :] + sa[..., None] * b_t[:, :, None, :] + v_t[..., None] * k_t[:, :, None, :]
        return S, jnp.einsum('bhij,bhj->bhi', S, r_t)

    xs = tuple(jnp.moveaxis(t, 1, 0) for t in (r, w, k, v, a, b))
    sT, ys = lax.scan(step, s0, xs)
    return jnp.moveaxis(ys, 0, 1), sT


def rwkv7(pr, sh0, s0, W, j):
    B, T, _ = pr.shape
    prev = jnp.concatenate([sh0[:, None].astype(pr.dtype), pr[:, :-1]], axis=1)
    pm = pr + (prev - pr) * W['rw_mu'][j]
    r, w_in, k, v, a_in, g_in = jnp.split(pm, RW_SPLITS, axis=-1)
    w = -jax.nn.softplus(-(W['rw_w0'][j] + jnp.tanh(w_in) @ W['rw_w2'][j])) - 0.5
    a = jax.nn.sigmoid(W['rw_a0'][j] + a_in @ W['rw_a2'][j])
    g = jax.nn.sigmoid(g_in) @ W['rw_g2'][j]

    def heads(t):
        return t.reshape(B, T, RW_HEADS, RW_N)

    kk = heads(k * W['rw_k_k'][j]).astype(jnp.float32)
    kk = kk / jnp.maximum(jnp.sqrt(jnp.sum(kk * kk, axis=-1, keepdims=True)), 1e-12)
    k = k * (1 + (a - 1) * W['rw_k_a'][j])
    rh, kh, vh, ah = [heads(t).astype(jnp.float32) for t in (r, k, v, a)]
    decay = jnp.exp(-jnp.exp(heads(w).astype(jnp.float32)))
    y, sT = wkv7_scan(rh, decay, kh, vh, -kk, kk * ah, s0.astype(jnp.float32))
    mu = jnp.mean(y, axis=-1, keepdims=True)
    var = jnp.mean(jnp.square(y - mu), axis=-1, keepdims=True)
    yn = ((y - mu) * lax.rsqrt(var + RW_GN_EPS)).reshape(B, T, RW_C) * W['rw_ln_w'][j] + W['rw_ln_b'][j]
    bonus = (jnp.sum(rh * kh * W['rw_r_k'][j], axis=-1, keepdims=True) * vh).reshape(B, T, RW_C)
    out = ((yn + bonus) * g).astype(pr.dtype)
    return out, sT.astype(s0.dtype), pr[:, -1]


def even_mixer(h, start, past, W, j):
    B, T, _ = h.shape
    proj = h @ W['even_w_in'][j]
    cq = proj[..., :MLA_Q_LORA]
    ckv = proj[..., MLA_Q_LORA:MLA_Q_LORA + MLA_KV_LORA]
    kr = proj[..., MLA_Q_LORA + MLA_KV_LORA:MLA_COLS]
    prw = proj[..., MLA_COLS:]
    pos = (start + jnp.arange(T)).astype(jnp.float32)
    q = jnp.einsum('btl,lhe->bthe', rms_norm(cq, W['mla_q_norm'][j]), W['mla_w_uq'][j])
    qn, qr = q[..., :MLA_NOPE], rope(q[..., MLA_NOPE:], pos)
    ckv = rms_norm(ckv, W['mla_kv_norm'][j])
    kr = rope(kr, pos)
    if past is None:
        kn, v = mla_expand(ckv, W['mla_w_ukv'][j])
        att = mla_prompt(qn, qr, kn, kr, v)
        s0 = jnp.zeros((B, RW_HEADS, RW_N, RW_N), h.dtype)
        sh0 = jnp.zeros((B, RW_COLS), h.dtype)
    else:
        ckv_past, kr_past, s0, sh0 = past
        kn, v = mla_expand(jnp.concatenate([ckv_past, ckv], axis=1), W['mla_w_ukv'][j])
        att = mla_attend(qn, qr, kn, jnp.concatenate([kr_past, kr], axis=1), v, None)
    y_rw, sT, shT = rwkv7(prw, sh0, s0, W, j)
    out = jnp.concatenate([att.reshape(B, T, MLA_HEADS * MLA_V), y_rw], axis=-1) @ W['even_w_out'][j]
    return out, (ckv, kr, sT, shT)


def alibi_slopes():
    hh = jnp.arange(1, SW_HEADS + 1, dtype=jnp.float32)
    return (2.0 ** (-8.0 * hh / SW_HEADS)).reshape(SW_KV_HEADS, SW_GROUP)


def sink_softmax(s, sinks):
    sk = sinks.astype(jnp.float32)[:, :, None, None]
    m = jnp.maximum(jnp.max(s, axis=-1, keepdims=True), sk)
    e = jnp.exp(s - m)
    return e / (jnp.sum(e, axis=-1, keepdims=True) + jnp.exp(sk - m))


def swa_prompt(q, k, v, sinks, slopes):
    B, T, HK, G, HD = q.shape
    nc = T // CHUNK
    pad = WIN_CHUNKS * CHUNK
    band = pad + CHUNK

    def bands(t):
        tp = jnp.pad(t, ((0, 0), (pad, 0), (0, 0), (0, 0))).reshape(B, nc + WIN_CHUNKS, CHUNK, HK, HD)
        return jnp.concatenate([tp[:, i:i + nc] for i in range(WIN_CHUNKS + 1)], axis=2)

    kb, vb = bands(k), bands(v)
    qb = q.reshape(B, nc, CHUNK, HK, G, HD)
    s = jnp.einsum('bnqkgd,bnskd->bnkgqs', qb, kb).astype(jnp.float32) * SW_HD ** -0.5
    qi = jnp.arange(CHUNK)
    kj = jnp.arange(band)
    dist = jnp.abs(qi[:, None] + pad - kj[None, :]).astype(jnp.float32)
    kpos = jnp.arange(nc)[:, None] * CHUNK - pad + kj[None, :]
    valid = (kpos >= 0)[:, None, None, None, :]
    s = jnp.where(valid, s - slopes[:, :, None, None] * dist, NEG)
    p = sink_softmax(s, sinks).astype(v.dtype)
    o = jnp.einsum('bnkgqs,bnskd->bnqkgd', p, vb)
    return o.reshape(B, T, HK, G, HD)


def swa_sample(q, k, v, start, n_past, sinks, slopes):
    T = q.shape[1]
    qpos = start + jnp.arange(T)
    kpos = start - n_past + jnp.arange(n_past + T)
    dist = jnp.abs(qpos[:, None] - kpos[None, :]).astype(jnp.float32)
    s = jnp.einsum('bqkgd,bskd->bkgqs', q, k).astype(jnp.float32) * SW_HD ** -0.5
    s = s - slopes[:, :, None, None] * dist
    p = sink_softmax(s, sinks).astype(v.dtype)
    return jnp.einsum('bkgqs,bskd->bqkgd', p, v)


def odd_mixer(h, start, past, W, j):
    B, T, _ = h.shape
    qkv = h @ W['odd_w_qkv'][j] + W['odd_b_qkv'][j]
    q = qkv[..., :ODD_MIX].reshape(B, T, SW_KV_HEADS, SW_GROUP, SW_HD)
    k = qkv[..., ODD_MIX:ODD_MIX + SW_KV_HEADS * SW_HD].reshape(B, T, SW_KV_HEADS, SW_HD)
    v = qkv[..., ODD_MIX + SW_KV_HEADS * SW_HD:].reshape(B, T, SW_KV_HEADS, SW_HD)
    slopes = alibi_slopes()
    sinks = W['swa_sinks'][j].reshape(SW_KV_HEADS, SW_GROUP)
    if past is None:
        o = swa_prompt(q, k, v, sinks, slopes)
        keep = min(WINDOW, T)
        k_new, v_new = k[:, T - keep:], v[:, T - keep:]
    else:
        k_past, v_past = past
        n_past = k_past.shape[1]
        k_all = jnp.concatenate([k_past, k], axis=1)
        v_all = jnp.concatenate([v_past, v], axis=1)
        o = swa_sample(q, k_all, v_all, start, n_past, sinks, slopes)
        k_new, v_new = k_all[:, T:], v_all[:, T:]
    out = o.reshape(B, T, ODD_MIX) @ W['odd_w_out'][j]
    return out, (k_new, v_new)


def trunk(x, c, start, past, W):
    B = x.shape[0]
    cs = jax.nn.silu(c)
    new_even, new_odd = [], []
    for i in range(DEPTH):
        mods = (cs @ W['w_ada'][i] + W['b_ada'][i]).reshape(B, 3 * N_SUB, D_MODEL)
        sh1, sc1, g1, sh2, sc2, g2, sh3, sc3, g3 = [mods[:, n] for n in range(3 * N_SUB)]
        x = x + 0.5 * g1[:, None] * swiglu(modulate(x, W['norm_g'][i, 0], sh1, sc1),
                                           W['ffn_w_in'][i, 0], W['ffn_w_out'][i, 0])
        h = modulate(x, W['norm_g'][i, 1], sh2, sc2)
        j = i // 2
        if i % 2 == 0:
            pst = None if past is None else (past[0][j], past[1][j], past[2][j], past[3][j])
            m, st = even_mixer(h, start, pst, W, j)
            new_even.append(st)
        else:
            pst = None if past is None else (past[4][j], past[5][j])
            m, st = odd_mixer(h, start, pst, W, j)
            new_odd.append(st)
        x = x + g2[:, None] * m
        x = x + 0.5 * g3[:, None] * swiglu(modulate(x, W['norm_g'][i, 2], sh3, sc3),
                                           W['ffn_w_in'][i, 1], W['ffn_w_out'][i, 1])
    even_states = [jnp.stack([st[n] for st in new_even]) for n in range(4)]
    odd_states = [jnp.stack([st[n] for st in new_odd]) for n in range(2)]
    return rms_norm(x, W['final_norm_g']), even_states + odd_states


def setup_inputs(seed: int = 0) -> dict:
    key = jax.random.key(seed)
    ks = iter(jax.random.split(key, 48))

    def nrm(shape, s):
        return jax.random.normal(next(ks), shape, jnp.float32) * s

    keep = min(WINDOW, PAST_LEN)
    d = {}
    d['x_prompt'] = nrm((BATCH, SEQ, D_MODEL), 1.0)
    d['x_sample'] = nrm((DEC_BATCH, DEC_SEQ, D_MODEL), 1.0)
    d['cache_mla_ckv'] = nrm((N_EVEN, DEC_BATCH, PAST_LEN, MLA_KV_LORA), 1.0)
    d['cache_mla_krope'] = nrm((N_EVEN, DEC_BATCH, PAST_LEN, MLA_ROPE), 1.0)
    d['state_rwkv'] = nrm((N_EVEN, DEC_BATCH, RW_HEADS, RW_N, RW_N), 0.5)
    d['state_rwkv_shift'] = nrm((N_EVEN, DEC_BATCH, RW_COLS), 1.0)
    d['cache_swa_k'] = nrm((N_ODD, DEC_BATCH, keep, SW_KV_HEADS, SW_HD), 1.0)
    d['cache_swa_v'] = nrm((N_ODD, DEC_BATCH, keep, SW_KV_HEADS, SW_HD), 1.0)
    d['c_prompt'] = nrm((BATCH, D_MODEL), 1.0)
    d['c_sample'] = nrm((DEC_BATCH, D_MODEL), 1.0)
    d['w_ada'] = nrm((DEPTH, D_MODEL, 3 * N_SUB * D_MODEL), 0.5 * D_MODEL ** -0.5)
    d['b_ada'] = nrm((DEPTH, 3 * N_SUB * D_MODEL), 0.02)
    d['norm_g'] = 1.0 + nrm((DEPTH, N_SUB, D_MODEL), 0.02)
    d['ffn_w_in'] = nrm((DEPTH, 2, D_MODEL, 2 * D_FF), D_MODEL ** -0.5)
    d['ffn_w_out'] = nrm((DEPTH, 2, D_FF, D_MODEL), D_FF ** -0.5)
    d['even_w_in'] = nrm((N_EVEN, D_MODEL, EVEN_IN), D_MODEL ** -0.5)
    d['even_w_out'] = nrm((N_EVEN, EVEN_MIX, D_MODEL), EVEN_MIX ** -0.5)
    d['mla_q_norm'] = 1.0 + nrm((N_EVEN, MLA_Q_LORA), 0.02)
    d['mla_kv_norm'] = 1.0 + nrm((N_EVEN, MLA_KV_LORA), 0.02)
    d['mla_w_uq'] = nrm((N_EVEN, MLA_Q_LORA, MLA_HEADS, MLA_NOPE + MLA_ROPE), MLA_Q_LORA ** -0.5)
    d['mla_w_ukv'] = nrm((N_EVEN, MLA_KV_LORA, MLA_HEADS, MLA_NOPE + MLA_V), MLA_KV_LORA ** -0.5)
    d['rw_mu'] = jax.random.uniform(next(ks), (N_EVEN, RW_COLS), jnp.float32)
    d['rw_w0'] = -1.0 + nrm((N_EVEN, RW_C), 0.5)
    d['rw_w2'] = nrm((N_EVEN, RW_DECAY_LORA, RW_C), 0.5 * RW_DECAY_LORA ** -0.5)
    d['rw_a0'] = nrm((N_EVEN, RW_C), 0.5)
    d['rw_a2'] = nrm((N_EVEN, RW_A_LORA, RW_C), 0.5 * RW_A_LORA ** -0.5)
    d['rw_g2'] = nrm((N_EVEN, RW_G_LORA, RW_C), RW_G_LORA ** -0.5)
    d['rw_k_k'] = 1.0 + nrm((N_EVEN, RW_C), 0.1)
    d['rw_k_a'] = 1.0 + nrm((N_EVEN, RW_C), 0.1)
    d['rw_r_k'] = nrm((N_EVEN, RW_HEADS, RW_N), 0.1)
    d['rw_ln_w'] = 1.0 + nrm((N_EVEN, RW_C), 0.02)
    d['rw_ln_b'] = nrm((N_EVEN, RW_C), 0.02)
    d['odd_w_qkv'] = nrm((N_ODD, D_MODEL, ODD_IN), D_MODEL ** -0.5)
    d['odd_b_qkv'] = nrm((N_ODD, ODD_IN), 0.02)
    d['odd_w_out'] = nrm((N_ODD, ODD_MIX, D_MODEL), ODD_MIX ** -0.5)
    d['swa_sinks'] = nrm((N_ODD, SW_HEADS), 0.5)
    d['final_norm_g'] = 1.0 + nrm((D_MODEL,), 0.02)
    return d


def reference(x_prompt, x_sample, cache_mla_ckv, cache_mla_krope, state_rwkv, state_rwkv_shift,
              cache_swa_k, cache_swa_v, c_prompt, c_sample, w_ada, b_ada, norm_g, ffn_w_in, ffn_w_out,
              even_w_in, even_w_out, mla_q_norm, mla_kv_norm, mla_w_uq, mla_w_ukv, rw_mu, rw_w0, rw_w2,
              rw_a0, rw_a2, rw_g2, rw_k_k, rw_k_a, rw_r_k, rw_ln_w, rw_ln_b, odd_w_qkv, odd_b_qkv,
              odd_w_out, swa_sinks, final_norm_g):
    W = dict(w_ada=w_ada, b_ada=b_ada, norm_g=norm_g, ffn_w_in=ffn_w_in, ffn_w_out=ffn_w_out,
             even_w_in=even_w_in, even_w_out=even_w_out, mla_q_norm=mla_q_norm, mla_kv_norm=mla_kv_norm,
             mla_w_uq=mla_w_uq, mla_w_ukv=mla_w_ukv, rw_mu=rw_mu, rw_w0=rw_w0, rw_w2=rw_w2, rw_a0=rw_a0,
             rw_a2=rw_a2, rw_g2=rw_g2, rw_k_k=rw_k_k, rw_k_a=rw_k_a, rw_r_k=rw_r_k, rw_ln_w=rw_ln_w,
             rw_ln_b=rw_ln_b, odd_w_qkv=odd_w_qkv, odd_b_qkv=odd_b_qkv, odd_w_out=odd_w_out,
             swa_sinks=swa_sinks, final_norm_g=final_norm_g)
    y_prompt, sp = trunk(x_prompt, c_prompt, 0, None, W)
    past = (cache_mla_ckv, cache_mla_krope, state_rwkv, state_rwkv_shift, cache_swa_k, cache_swa_v)
    y_sample, ss = trunk(x_sample, c_sample, cache_mla_ckv.shape[2], past, W)
    return (y_prompt, y_sample, sp[0], sp[1], sp[2], sp[3], sp[4], sp[5],
            ss[0], ss[1], ss[2], ss[3], ss[4], ss[5])
```

```cpp
#include <hip/hip_runtime.h>
#include <hip/hip_cooperative_groups.h>
#include <stdint.h>
#include <stdio.h>
namespace cg = cooperative_groups;

typedef unsigned short bf16_t;
typedef short bf16x8 __attribute__((ext_vector_type(8)));
typedef float f32x4 __attribute__((ext_vector_type(4)));
typedef float f32x2 __attribute__((ext_vector_type(2)));
typedef unsigned u32x4 __attribute__((ext_vector_type(4)));
#define LAS __attribute__((address_space(3)))

constexpr int MT = 33792, MP = 32768;
constexpr long KROWS = 99328;
constexpr long SROWS = 35840;
constexpr int NTHR = 512;
constexpr int HT_ = 256;
constexpr int SMEM_BYTES = 131072;
constexpr int HALF_LDS = 40960;

constexpr long O_Y = 0;
constexpr long O_PCKV = 34603008;
constexpr long O_PKR = O_PCKV + 16777216;
constexpr long O_PRW = O_PKR + 2097152;
constexpr long O_PSH = O_PRW + 131072;
constexpr long O_PSK = O_PSH + 7168;
constexpr long O_PSV = O_PSK + 131072;
constexpr long O_SCKV = O_PSV + 131072;
constexpr long O_SKR = O_SCKV + 524288;
constexpr long O_SRW = O_SKR + 65536;
constexpr long O_SSH = O_SRW + 1048576;
constexpr long O_SSK = O_SSH + 57344;
constexpr long O_SSV = O_SSK + 1048576;

constexpr size_t WS_MODS = 16384;
constexpr size_t WS_ROPE = WS_MODS + 4ull * 18 * 9216 * 4;
constexpr size_t WS_W = WS_ROPE + 16384ull * 32 * 4;
constexpr size_t W_FI = WS_W;
constexpr size_t W_FO = W_FI + 2ull * 5632 * 1024 * 2;
constexpr size_t W_EI = W_FO + 2ull * 1024 * 2816 * 2;
constexpr size_t W_EO = W_EI + 3072ull * 1024 * 2;
constexpr size_t W_UQ = W_EO + 1024ull * 1024 * 2;
constexpr size_t W_UKV = W_UQ + 768ull * 768 * 2;
constexpr size_t W_W2 = W_UKV + 1024ull * 256 * 2;
constexpr size_t W_A2 = W_W2 + 512ull * 64 * 2;
constexpr size_t W_G2 = W_A2 + 512ull * 64 * 2;
constexpr size_t W_OQ = W_G2 + 512ull * 128 * 2;
constexpr size_t W_OO = W_OQ + 1536ull * 1024 * 2;
constexpr size_t WS_H = W_OO + 1024ull * 1024 * 2;
constexpr size_t WS_BIG = WS_H + (size_t)MT * 1024 * 2;
constexpr size_t BIG_BYTES = (size_t)MT * 3072 * 2;
constexpr size_t B_Q = WS_BIG;
constexpr size_t B_E = B_Q + (size_t)MT * 768 * 2;
constexpr size_t B_AA = B_E + (size_t)MT * 512 * 2;
constexpr size_t B_G = B_AA + (size_t)MT * 512 * 2;
constexpr size_t B_PB = B_G + (size_t)MT * 512 * 2;
constexpr size_t B_SWK = WS_BIG + (size_t)MT * 1024 * 2;
constexpr size_t B_SWVT = B_SWK + (size_t)SROWS * 256 * 2;
constexpr size_t WS_A = WS_BIG + BIG_BYTES;
constexpr size_t A_CQN = WS_A;
constexpr size_t A_QT = WS_A;
constexpr size_t A_U = WS_A + (size_t)MP * 512 * 2;
constexpr size_t A_LORA = A_CQN + (size_t)MT * 768 * 2;
constexpr size_t A_CKV = A_LORA + (size_t)MT * 256 * 2;
constexpr size_t A_KR = A_CKV + (size_t)KROWS * 256 * 2;
constexpr size_t A_R = A_KR + (size_t)KROWS * 32 * 2;
constexpr size_t A_K = A_R + (size_t)MT * 512 * 2;
constexpr size_t A_V = A_K + (size_t)MT * 512 * 2;
constexpr size_t WS_C = A_V + (size_t)MT * 512 * 2;
constexpr size_t C_KN = WS_C;
constexpr size_t C_VT = C_KN + (size_t)KROWS * 512 * 2;
constexpr size_t WS_END = C_VT + (size_t)KROWS * 512 * 2;
static_assert(B_PB + 2048ull * 4096 * 2 <= WS_BIG + BIG_BYTES, "big overflow");
static_assert(B_SWVT + (size_t)SROWS * 256 * 2 <= WS_BIG + BIG_BYTES, "big overflow odd");
static_assert(A_U + 2048ull * 4096 * 4 <= A_CKV, "U overlaps live data");
static_assert(WS_END < 785ull * 1024 * 1024, "ws too big");

struct Params {
    const float* in[37];
    float* out;
    char* ws;
};
typedef const __attribute__((address_space(4))) Params* PP;

__device__ __forceinline__ int tid_opaque() { int t = threadIdx.x; asm volatile("" : "+v"(t)); return t; }
#define TIDX tid_opaque()
#define TH (tid_opaque() & 255)
typedef __bf16 bf16v2_t __attribute__((ext_vector_type(2)));
typedef __bf16 bf16v8_t __attribute__((ext_vector_type(8)));
typedef float f32x8 __attribute__((ext_vector_type(8)));
__device__ __forceinline__ uint32_t pack2(float lo, float hi) { const f32x2 v = {lo, hi}; return __builtin_bit_cast(uint32_t, __builtin_convertvector(v, bf16v2_t)); }
__device__ __forceinline__ bf16_t f2bf(float f) { return (bf16_t)(pack2(f, 0.f) & 0xffffu); }
__device__ __forceinline__ float bf2f(bf16_t h) { return __uint_as_float(((uint32_t)h) << 16); }
__device__ __forceinline__ void seqinfo(int row, int& s, int& t) {
    if (row < MP) { s = row >> 14; t = row & 16383; }
    else { int r = row - MP; s = 2 + (r >> 6); t = r & 63; }
}
__device__ __forceinline__ float wave_sum(float v) {
#pragma unroll
    for (int o = 32; o >= 1; o >>= 1) v += __shfl_xor(v, o);
    return v;
}
__device__ __forceinline__ float sigmoidf_(float x) { return __builtin_amdgcn_rcpf(1.0f + __builtin_amdgcn_exp2f(-1.4426950408889634f * x)); }
#define WAVE_SYNC() do { __builtin_amdgcn_wave_barrier(); asm volatile("s_waitcnt lgkmcnt(0)" ::: "memory"); __builtin_amdgcn_wave_barrier(); } while (0)

__device__ __forceinline__ int srccol(int map, int n) {
    switch (map) {
        case 1: { int nt = n >> 8, lr = n & 255; return nt * 128 + (lr & 127) + (lr >= 128 ? 2816 : 0); }
        case 2: return n < 2848 ? n : -1;
        case 3: { if (n < 512) { int h = n >> 6, e = n & 63; return h * 96 + e; } int m = n - 512; int h = m >> 5, i = m & 31; return h * 96 + 64 + i; }
        case 4: { if (n < 512) { int h = n >> 6, e = n & 63; return h * 128 + e; } int m = n - 512; int h = m >> 6, d = m & 63; return h * 128 + 64 + d; }
        default: return n;
    }
}
struct ConvD { const float* src; int K, ld; bf16_t* dst; int map, idx; };
__device__ __forceinline__ void conv_load(const ConvD& d, f32x4 (&v)[4]) {
    const int KT = d.K >> 6;
    const int kt = d.idx % KT, nt = d.idx / KT;
    const int k0 = kt * 64, n0 = nt * 64;
    const int tid = TH;
    const int tk = tid >> 4, tn4 = (tid & 15) * 4;
    const int sc = srccol(d.map, n0 + tn4);
#pragma unroll
    for (int kk = 0; kk < 4; ++kk) {
        v[kk] = (f32x4){0.f, 0.f, 0.f, 0.f};
        if (sc >= 0) v[kk] = *(const f32x4*)(d.src + (long)(k0 + tk + 16 * kk) * d.ld + sc);
    }
}
__device__ __forceinline__ void conv_store(const ConvD& d, const f32x4 (&v)[4], char* smem) {
    float* sm = (float*)smem;
    const int KT = d.K >> 6;
    const int kt = d.idx % KT, nt = d.idx / KT;
    const int k0 = kt * 64, n0 = nt * 64;
    const int tid = TH;
    __syncthreads();
    {
        const int tk = tid >> 4, tn4 = (tid & 15) * 4;
#pragma unroll
        for (int kk = 0; kk < 4; ++kk) {
            const int k = tk + 16 * kk;
            sm[k * 65 + tn4 + 0] = v[kk][0]; sm[k * 65 + tn4 + 1] = v[kk][1]; sm[k * 65 + tn4 + 2] = v[kk][2]; sm[k * 65 + tn4 + 3] = v[kk][3];
        }
    }
    __syncthreads();
    {
        const int n = tid >> 2, kc = tid & 3;
        uint32_t w[8];
#pragma unroll
        for (int i = 0; i < 8; ++i) w[i] = pack2(sm[(kc * 16 + 2 * i) * 65 + n], sm[(kc * 16 + 2 * i + 1) * 65 + n]);
        u32x4* dd = (u32x4*)(d.dst + (long)(n0 + n) * d.K + k0 + kc * 16);
        dd[0] = (u32x4){w[0], w[1], w[2], w[3]};
        dd[1] = (u32x4){w[4], w[5], w[6], w[7]};
    }
}
#define CONV_TRY(SRC, K_, LD_, DSTOFF, ND, MAP) { const int nt_ = ((K_) / 64) * ((ND) / 64); if (idx < nt_) { d.src = (SRC); d.K = (K_); d.ld = (LD_); d.dst = (bf16_t*)(p->ws + (DSTOFF)); d.map = (MAP); d.idx = idx; return d; } idx -= nt_; }
__device__ __forceinline__ int conv_count(int l) {
    const int ffn = 2 * 1408 + 2 * 704;
    return (l & 1) ? ffn + 384 + 256 : ffn + 768 + 256 + 144 + 64 + 8 + 8 + 16;
}
__device__ __forceinline__ ConvD conv_desc(PP p, int l, int idx) {
    ConvD d; d.src = nullptr; d.K = 64; d.ld = 0; d.dst = nullptr; d.map = 0; d.idx = 0;
    const int j = l >> 1;
    CONV_TRY(p->in[13] + (long)(l * 2 + 0) * 1024 * 5632, 1024, 5632, W_FI, 5632, 1)
    CONV_TRY(p->in[13] + (long)(l * 2 + 1) * 1024 * 5632, 1024, 5632, W_FI + 5632ull * 1024 * 2, 5632, 1)
    CONV_TRY(p->in[14] + (long)(l * 2 + 0) * 2816 * 1024, 2816, 1024, W_FO, 1024, 0)
    CONV_TRY(p->in[14] + (long)(l * 2 + 1) * 2816 * 1024, 2816, 1024, W_FO + 1024ull * 2816 * 2, 1024, 0)
    if (l & 1) {
        CONV_TRY(p->in[32] + (long)j * 1024 * 1536, 1024, 1536, W_OQ, 1536, 0)
        CONV_TRY(p->in[34] + (long)j * 1024 * 1024, 1024, 1024, W_OO, 1024, 0)
    } else {
        CONV_TRY(p->in[15] + (long)j * 1024 * 2848, 1024, 2848, W_EI, 3072, 2)
        CONV_TRY(p->in[16] + (long)j * 1024 * 1024, 1024, 1024, W_EO, 1024, 0)
        CONV_TRY(p->in[19] + (long)j * 768 * 768, 768, 768, W_UQ, 768, 3)
        CONV_TRY(p->in[20] + (long)j * 256 * 1024, 256, 1024, W_UKV, 1024, 4)
        CONV_TRY(p->in[23] + (long)j * 64 * 512, 64, 512, W_W2, 512, 0)
        CONV_TRY(p->in[25] + (long)j * 64 * 512, 64, 512, W_A2, 512, 0)
        CONV_TRY(p->in[26] + (long)j * 128 * 512, 128, 512, W_G2, 512, 0)
    }
    return d;
}
__device__ __forceinline__ void conv_phase(PP p, int l, int bid, int G, char* smem) {
    const int half = TIDX >> 8;
    const int nc = conv_count(l);
    int idx = bid * 2;
    if (idx >= nc) return;
    f32x4 nv[4];
    ConvD nd = conv_desc(p, l, idx + half);
    conv_load(nd, nv);
    for (;;) {
        const ConvD cd = nd;
        f32x4 cv[4];
#pragma unroll
        for (int i = 0; i < 4; ++i) cv[i] = nv[i];
        const int nidx = idx + G * 2;
        if (nidx < nc) { nd = conv_desc(p, l, nidx + half); conv_load(nd, nv); }
        conv_store(cd, cv, smem + half * HALF_LDS);
        if (nidx >= nc) break;
        idx = nidx;
    }
}

__device__ __forceinline__ int swz(int r, int c) { return r * 64 + ((c ^ ((-(r >> 2)) & 3)) << 4); }

__device__ __forceinline__ void gemm_core(const bf16_t* __restrict__ A, long lda, const bf16_t* __restrict__ Bt, long ldb, int K,
                                          char* smem, f32x4 (&acc)[4][4]) {
    const int tid = TH, lane = tid & 63, w = tid >> 6, wm = w >> 1, wn = w & 1, lr = lane & 15, lq = lane >> 4;
    char* sA = smem;
    char* sB = smem + 16384;
#pragma unroll
    for (int mi = 0; mi < 4; ++mi)
#pragma unroll
        for (int ni = 0; ni < 4; ++ni) acc[mi][ni] = (f32x4){0.f, 0.f, 0.f, 0.f};
    const int lrow = tid >> 3, c8 = tid & 7;
    const bf16_t* ga = A + (long)lrow * lda + c8 * 8;
    const bf16_t* gb = Bt + (long)lrow * ldb + c8 * 8;
    const int loff = (c8 >> 2) * 8192;
    u32x4 ra[4], rb[4];
#pragma unroll
    for (int i = 0; i < 4; ++i) { ra[i] = *(const u32x4*)(ga + (long)(32 * i) * lda); rb[i] = *(const u32x4*)(gb + (long)(32 * i) * ldb); }
    const int KT = K >> 6;
    for (int kt = 0; kt < KT; ++kt) {
        __syncthreads();
#pragma unroll
        for (int i = 0; i < 4; ++i) {
            const int r = lrow + 32 * i;
            *(u32x4*)(sA + loff + swz(r, c8 & 3)) = ra[i];
            *(u32x4*)(sB + loff + swz(r, c8 & 3)) = rb[i];
        }
        __syncthreads();
        if (kt + 1 < KT) {
            const int k0 = (kt + 1) * 64;
#pragma unroll
            for (int i = 0; i < 4; ++i) { ra[i] = *(const u32x4*)(ga + (long)(32 * i) * lda + k0); rb[i] = *(const u32x4*)(gb + (long)(32 * i) * ldb + k0); }
        }
#pragma unroll
        for (int sub = 0; sub < 2; ++sub) {
            bf16x8 af[4], bfr[4];
#pragma unroll
            for (int mi = 0; mi < 4; ++mi) af[mi] = *(const bf16x8*)(sA + sub * 8192 + swz(wm * 64 + mi * 16 + lr, lq));
#pragma unroll
            for (int ni = 0; ni < 4; ++ni) bfr[ni] = *(const bf16x8*)(sB + sub * 8192 + swz(wn * 64 + ni * 16 + lr, lq));
#pragma unroll
            for (int mi = 0; mi < 4; ++mi)
#pragma unroll
                for (int ni = 0; ni < 4; ++ni) acc[mi][ni] = __builtin_amdgcn_mfma_f32_16x16x32_bf16(af[mi], bfr[ni], acc[mi][ni], 0, 0, 0);
        }
    }
}
__device__ __forceinline__ void tile_map(int T, int MTl, int NTl, int& mt, int& nt) {
    const int per_group = 8 * NTl;
    const int g = T / per_group, r = T - g * per_group;
    const int rem = MTl - g * 8;
    const int gsz = rem < 8 ? rem : 8;
    mt = g * 8 + r % gsz; nt = r / gsz;
}
#define EPI_IDX const int tid_ = TH, lane_ = tid_ & 63, w_ = tid_ >> 6, wm_ = w_ >> 1, wn_ = w_ & 1, lr_ = lane_ & 15, lq_ = lane_ >> 4; \
    const int rbase_ = mt * 128 + wm_ * 64 + lq_ * 4, cbase_ = nt * 128 + wn_ * 64 + lr_;

constexpr float QS_MLA = 0.10206207261596577f * 1.4426950408889634f;
constexpr float QS_SWA = 0.125f * 1.4426950408889634f;
constexpr int G_HT = 128 * 64;
__device__ __forceinline__ int lds_byte(int r, int c) {
    int st = (r >> 4) * 2 + (c >> 5), rr = r & 15, cc = c & 31, ob = rr * 64 + cc * 2;
    return st * 1024 + (ob ^ (((ob >> 9) & 1) << 5));
}
__device__ __forceinline__ void stage_rc(int b, int& R, int& C) {
    int st = b / 1024, sb = b % 1024, swz = sb ^ (((sb >> 9) & 1) << 5);
    R = (st >> 1) * 16 + swz / 64; C = (st & 1) * 32 + (swz % 64) / 2;
}
#define G_AS1 __attribute__((address_space(1)))
__device__ __forceinline__ void gemm256(const bf16_t* __restrict__ A, long lda, const bf16_t* __restrict__ Bt, long ldb, int K,
                                        int brow, int bcol, char* smem, f32x4 (&acc)[2][2][4][2]) {
    bf16_t* shm = (bf16_t*)smem;
    const int tid = TIDX;
#define SA(b, h) (shm + ((b) * 2 + (h)) * G_HT)
#define SB(b, h) (shm + (4 + (b) * 2 + (h)) * G_HT)
#define STAGE(P, BASE, LD, br, kt) do { const long _g = (long)(br) * (LD) + (long)(kt) * 64; \
    _Pragma("unroll") for (int _i = 0; _i < 2; ++_i) { const int _b = tid * 16 + _i * 8192; int _r, _c; stage_rc(_b, _r, _c); \
      __builtin_amdgcn_global_load_lds((const G_AS1 unsigned*)((BASE) + _g + (long)_r * (LD) + _c), \
        (LAS unsigned*)((char*)(P) + _b), 16, 0, 0); } } while (0)
#define LDA(dst, b, h) _Pragma("unroll") for (int m = 0; m < 4; ++m) _Pragma("unroll") for (int k = 0; k < 2; ++k) \
    dst[m][k] = *reinterpret_cast<const bf16x8*>((char*)SA(b, h) + lds_byte(wr * 64 + m * 16 + fr, k * 32 + fq * 8))
#define LDB(dst, b, h) _Pragma("unroll") for (int n = 0; n < 2; ++n) _Pragma("unroll") for (int k = 0; k < 2; ++k) \
    dst[n][k] = *reinterpret_cast<const bf16x8*>((char*)SB(b, h) + lds_byte(wc * 32 + n * 16 + fr, k * 32 + fq * 8))
#define MMA(ai, bj, At_, Bt_) do { __builtin_amdgcn_s_setprio(1); \
    _Pragma("unroll") for (int m = 0; m < 4; ++m) _Pragma("unroll") for (int n = 0; n < 2; ++n) _Pragma("unroll") for (int k = 0; k < 2; ++k) \
      acc[ai][bj][m][n] = __builtin_amdgcn_mfma_f32_16x16x32_bf16(At_[m][k], Bt_[n][k], acc[ai][bj][m][n], 0, 0, 0); \
    __builtin_amdgcn_s_setprio(0); } while (0)
#define WAIT_V(n) asm volatile("s_waitcnt vmcnt(" #n ")" ::: "memory")
#define WAIT_L(n) asm volatile("s_waitcnt lgkmcnt(" #n ")" ::: "memory")
#define BAR __builtin_amdgcn_s_barrier()
#define SCHED __builtin_amdgcn_sched_barrier(0)
    const int wid = tid >> 6, lane = tid & 63, wr = wid >> 2, wc = wid & 3, fr = lane & 15, fq = lane >> 4;
#pragma unroll
    for (int ai = 0; ai < 2; ++ai)
#pragma unroll
        for (int bj = 0; bj < 2; ++bj)
#pragma unroll
            for (int m = 0; m < 4; ++m)
#pragma unroll
                for (int n = 0; n < 2; ++n) acc[ai][bj][m][n] = (f32x4){0.f, 0.f, 0.f, 0.f};
    bf16x8 At[4][2], B0[2][2], B1[2][2];
    const int nt = K / 64;
    __syncthreads();
    STAGE(SB(0, 0), Bt, ldb, bcol, 0); STAGE(SA(0, 0), A, lda, brow, 0);
    STAGE(SB(0, 1), Bt, ldb, bcol + 128, 0); STAGE(SA(0, 1), A, lda, brow + 128, 0);
    if (wr == 1) BAR;
    WAIT_V(4); BAR;
    STAGE(SB(1, 0), Bt, ldb, bcol, 1); STAGE(SA(1, 0), A, lda, brow, 1); STAGE(SB(1, 1), Bt, ldb, bcol + 128, 1);
    WAIT_V(6); BAR;
    for (int t = 0; t < nt - 2; t += 2) {
        LDB(B0, 0, 0); SCHED; LDA(At, 0, 0); STAGE(SA(1, 1), A, lda, brow + 128, t + 1);
        WAIT_L(8); BAR; WAIT_L(0); MMA(0, 0, At, B0); BAR; SCHED;
        LDB(B1, 0, 1); STAGE(SB(0, 0), Bt, ldb, bcol, t + 2);
        BAR; WAIT_L(0); MMA(0, 1, At, B1); BAR;
        LDA(At, 0, 1); STAGE(SA(0, 0), A, lda, brow, t + 2);
        BAR; WAIT_L(0); MMA(1, 0, At, B0); BAR; SCHED;
        STAGE(SB(0, 1), Bt, ldb, bcol + 128, t + 2);
        WAIT_V(6); BAR; MMA(1, 1, At, B1); BAR;
        LDB(B0, 1, 0); SCHED; LDA(At, 1, 0); STAGE(SA(0, 1), A, lda, brow + 128, t + 2);
        WAIT_L(8); BAR; WAIT_L(0); MMA(0, 0, At, B0); BAR; SCHED;
        LDB(B1, 1, 1); STAGE(SB(1, 0), Bt, ldb, bcol, t + 3);
        BAR; WAIT_L(0); MMA(0, 1, At, B1); BAR;
        LDA(At, 1, 1); STAGE(SA(1, 0), A, lda, brow, t + 3);
        BAR; WAIT_L(0); MMA(1, 0, At, B0); BAR; SCHED;
        STAGE(SB(1, 1), Bt, ldb, bcol + 128, t + 3);
        WAIT_V(6); BAR; MMA(1, 1, At, B1); BAR;
    }
    { LDB(B0, 0, 0); LDA(At, 0, 0); STAGE(SA(1, 1), A, lda, brow + 128, nt - 1);
      BAR; WAIT_L(0); MMA(0, 0, At, B0); BAR;
      LDB(B1, 0, 1); BAR; WAIT_L(0); MMA(0, 1, At, B1); BAR;
      LDA(At, 0, 1); WAIT_V(4); BAR; WAIT_L(0); MMA(1, 0, At, B0); MMA(1, 1, At, B1); BAR; }
    { LDB(B0, 1, 0); LDA(At, 1, 0); WAIT_V(2); BAR; WAIT_L(0); MMA(0, 0, At, B0); BAR;
      LDB(B1, 1, 1); WAIT_V(0); BAR; WAIT_L(0); MMA(0, 1, At, B1); BAR;
      LDA(At, 1, 1); BAR; WAIT_L(0); MMA(1, 0, At, B0); MMA(1, 1, At, B1); BAR; }
    if (wr == 0) BAR;
}
__device__ __forceinline__ void tile_map256(int wgid, int nM, int nN, int& pm, int& pn) {
    const int nwg = nM * nN;
    { const int q = nwg / 8, r = nwg % 8, xcd = wgid % 8, off = wgid / 8; wgid = (xcd < r ? xcd * (q + 1) : r * (q + 1) + (xcd - r) * q) + off; }
    constexpr int WGM = 4;
    const int nig = WGM * nN, gid = wgid / nig, fm = gid * WGM;
    const int rem = nM - fm, gsz = rem < WGM ? rem : WGM;
    pm = fm + ((wgid % nig) % gsz); pn = (wgid % nig) / gsz;
}
#define EPI256 const int tid_ = TIDX, lane_ = tid_ & 63, wid_ = tid_ >> 6, wr_ = wid_ >> 2, wc_ = wid_ & 3, fr_ = lane_ & 15, fq_ = lane_ >> 4; \
    const int rb_ = pm * 256 + wr_ * 64 + fq_ * 4, cb_ = pn * 256 + wc_ * 32 + fr_;
#define ACC256 f32x4 acc[2][2][4][2]

__device__ __forceinline__ void t256_ffn_in(PP p, int wsel, int pm, int pn, char* smem) {
    ACC256;
    gemm256((const bf16_t*)(p->ws + WS_H), 1024, (const bf16_t*)(p->ws + W_FI) + (long)wsel * 5632 * 1024, 1024, 1024, pm * 256, pn * 256, smem, acc);
    EPI256
    bf16_t* U = (bf16_t*)(p->ws + WS_BIG);
#pragma unroll
    for (int ai = 0; ai < 2; ++ai)
#pragma unroll
        for (int m = 0; m < 4; ++m)
#pragma unroll
            for (int j = 0; j < 4; ++j) {
                const long row = rb_ + ai * 128 + m * 16 + j;
#pragma unroll
                for (int n = 0; n < 2; ++n) {
                    const int hu = pn * 128 + wc_ * 32 + n * 16 + fr_;
                    const float g = acc[ai][0][m][n][j], up = acc[ai][1][m][n][j];
                    U[row * 2816 + hu] = f2bf(g * sigmoidf_(g) * up);
                }
            }
}
__device__ __forceinline__ void t256_resid(PP p, const bf16_t* A0, long lda, const bf16_t* Bt0, int K, int l, int gi, float coef, int pm, int pn, char* smem,
                                           int k0 = 0, int klen = 0, bool atomic = false) {
    ACC256;
    if (klen == 0) klen = K;
    gemm256(A0 + k0, lda, Bt0 + k0, K, klen, pm * 256, pn * 256, smem, acc);
    EPI256
    const float* mods = (const float*)(p->ws + WS_MODS);
#pragma unroll
    for (int ai = 0; ai < 2; ++ai) {
        float xv[4][4][4], gv[4][4];
#pragma unroll
        for (int m = 0; m < 4; ++m) {
            const int row0 = rb_ + ai * 128 + m * 16;
            int s_, t_; seqinfo(row0, s_, t_);
            const float* gate = mods + ((long)(l * 18 + s_) * 9 + gi) * 1024;
#pragma unroll
            for (int c = 0; c < 4; ++c) gv[m][c] = coef * gate[cb_ + (c >> 1) * 128 + (c & 1) * 16];
            if (!atomic) {
#pragma unroll
                for (int j = 0; j < 4; ++j)
#pragma unroll
                    for (int c = 0; c < 4; ++c) xv[m][j][c] = p->out[(long)(row0 + j) * 1024 + cb_ + (c >> 1) * 128 + (c & 1) * 16];
            }
        }
#pragma unroll
        for (int m = 0; m < 4; ++m) {
            const int row0 = rb_ + ai * 128 + m * 16;
#pragma unroll
            for (int j = 0; j < 4; ++j)
#pragma unroll
                for (int c = 0; c < 4; ++c) {
                    float* xp = p->out + (long)(row0 + j) * 1024 + cb_ + (c >> 1) * 128 + (c & 1) * 16;
                    const float dv = gv[m][c] * acc[ai][c >> 1][m][c & 1][j];
                    if (atomic) atomicAdd(xp, dv); else *xp = xv[m][j][c] + dv;
                }
        }
    }
}
__device__ __forceinline__ void t256_even_in(PP p, int pm, int pn, char* smem) {
    ACC256;
    gemm256((const bf16_t*)(p->ws + WS_H), 1024, (const bf16_t*)(p->ws + W_EI), 1024, 1024, pm * 256, pn * 256, smem, acc);
    EPI256
    bf16_t* PJ = (bf16_t*)(p->ws + WS_BIG);
#pragma unroll
    for (int ai = 0; ai < 2; ++ai)
#pragma unroll
        for (int bj = 0; bj < 2; ++bj)
#pragma unroll
            for (int m = 0; m < 4; ++m)
#pragma unroll
                for (int n = 0; n < 2; ++n)
#pragma unroll
                    for (int j = 0; j < 4; ++j) PJ[(long)(rb_ + ai * 128 + m * 16 + j) * 3072 + cb_ + bj * 128 + n * 16] = f2bf(acc[ai][bj][m][n][j]);
}
__device__ __forceinline__ void t256_qup(PP p, int pm, int pn, char* smem) {
    ACC256;
    gemm256((const bf16_t*)(p->ws + A_CQN), 768, (const bf16_t*)(p->ws + W_UQ), 768, 768, pm * 256, pn * 256, smem, acc);
    EPI256
    bf16_t* Q = (bf16_t*)(p->ws + B_Q);
    const float* rope = (const float*)(p->ws + WS_ROPE);
    if (pn < 2) {
#pragma unroll
        for (int ai = 0; ai < 2; ++ai)
#pragma unroll
            for (int bj = 0; bj < 2; ++bj)
#pragma unroll
                for (int m = 0; m < 4; ++m)
#pragma unroll
                    for (int n = 0; n < 2; ++n)
#pragma unroll
                        for (int j = 0; j < 4; ++j) Q[(long)(rb_ + ai * 128 + m * 16 + j) * 768 + cb_ + bj * 128 + n * 16] = f2bf(acc[ai][bj][m][n][j] * QS_MLA);
    } else {
        float csv[2][4][4], snv[2][4][4];
#pragma unroll
        for (int ai = 0; ai < 2; ++ai)
#pragma unroll
            for (int m = 0; m < 4; ++m)
#pragma unroll
                for (int j = 0; j < 4; ++j) {
                    const int row = rb_ + ai * 128 + m * 16 + j;
                    int s, t; seqinfo(row, s, t);
                    const int pos = (row < MP) ? t : 4096 + t;
                    csv[ai][m][j] = rope[pos * 32 + fr_]; snv[ai][m][j] = rope[pos * 32 + 16 + fr_];
                }
#pragma unroll
        for (int ai = 0; ai < 2; ++ai)
#pragma unroll
            for (int m = 0; m < 4; ++m)
#pragma unroll
                for (int j = 0; j < 4; ++j) {
                    const int row = rb_ + ai * 128 + m * 16 + j;
                    const float cs = csv[ai][m][j], sn = snv[ai][m][j];
#pragma unroll
                    for (int bj = 0; bj < 2; ++bj) {
                        const float x1 = acc[ai][bj][m][0][j], x2 = acc[ai][bj][m][1][j];
                        const long o = (long)row * 768 + cb_ + bj * 128;
                        Q[o] = f2bf((x1 * cs - x2 * sn) * QS_MLA);
                        Q[o + 16] = f2bf((x1 * sn + x2 * cs) * QS_MLA);
                    }
                }
    }
}
__device__ __forceinline__ void t256_kvup(PP p, int pm, int pn, char* smem) {
    ACC256;
    gemm256((const bf16_t*)(p->ws + A_CKV), 256, (const bf16_t*)(p->ws + W_UKV), 256, 256, pm * 256, pn * 256, smem, acc);
    EPI256
    if (pn < 2) {
        bf16_t* KN = (bf16_t*)(p->ws + C_KN);
#pragma unroll
        for (int ai = 0; ai < 2; ++ai)
#pragma unroll
            for (int bj = 0; bj < 2; ++bj)
#pragma unroll
                for (int m = 0; m < 4; ++m)
#pragma unroll
                    for (int n = 0; n < 2; ++n)
#pragma unroll
                        for (int j = 0; j < 4; ++j) KN[(long)(rb_ + ai * 128 + m * 16 + j) * 512 + cb_ + bj * 128 + n * 16] = f2bf(acc[ai][bj][m][n][j]);
    } else {
        bf16_t* VT = (bf16_t*)(p->ws + C_VT);
#pragma unroll
        for (int ai = 0; ai < 2; ++ai)
#pragma unroll
            for (int bj = 0; bj < 2; ++bj)
#pragma unroll
                for (int m = 0; m < 4; ++m)
#pragma unroll
                    for (int n = 0; n < 2; ++n) {
                        const int d = cb_ + bj * 128 + n * 16 - 512;
                        uint2 v; v.x = pack2(acc[ai][bj][m][n][0], acc[ai][bj][m][n][1]); v.y = pack2(acc[ai][bj][m][n][2], acc[ai][bj][m][n][3]);
                        *(uint2*)(VT + (long)d * KROWS + rb_ + ai * 128 + m * 16) = v;
                    }
    }
}
__device__ __forceinline__ void t256_oddqkv(PP p, int jl, int pm, int pn, char* smem) {
    ACC256;
    gemm256((const bf16_t*)(p->ws + WS_H), 1024, (const bf16_t*)(p->ws + W_OQ), 1024, 1024, pm * 256, pn * 256, smem, acc);
    EPI256
    const float* bias = p->in[33] + jl * 1536;
    float bvv[2][2];
#pragma unroll
    for (int bj = 0; bj < 2; ++bj)
#pragma unroll
        for (int n = 0; n < 2; ++n) bvv[bj][n] = bias[cb_ + bj * 128 + n * 16];
    if (pn < 4) {
        bf16_t* Q = (bf16_t*)(p->ws + B_Q);
#pragma unroll
        for (int ai = 0; ai < 2; ++ai)
#pragma unroll
            for (int bj = 0; bj < 2; ++bj)
#pragma unroll
                for (int m = 0; m < 4; ++m)
#pragma unroll
                    for (int n = 0; n < 2; ++n)
#pragma unroll
                        for (int j = 0; j < 4; ++j) { const int col = cb_ + bj * 128 + n * 16; Q[(long)(rb_ + ai * 128 + m * 16 + j) * 1024 + col] = f2bf((acc[ai][bj][m][n][j] + bvv[bj][n]) * QS_SWA); }
    } else {
        const bool isK = pn == 4;
        bf16_t* SK = (bf16_t*)(p->ws + B_SWK);
        bf16_t* SVT = (bf16_t*)(p->ws + B_SWVT);
#pragma unroll
        for (int ai = 0; ai < 2; ++ai)
#pragma unroll
            for (int bj = 0; bj < 2; ++bj)
#pragma unroll
                for (int m = 0; m < 4; ++m)
#pragma unroll
                    for (int n = 0; n < 2; ++n) {
                        const int col = cb_ + bj * 128 + n * 16;
                        const int c = col - (isK ? 1024 : 1280);
                        const float bv = bvv[bj][n];
                        float v[4];
#pragma unroll
                        for (int j = 0; j < 4; ++j) v[j] = acc[ai][bj][m][n][j] + bv;
                        const int row0 = rb_ + ai * 128 + m * 16;
                        int s, t; seqinfo(row0, s, t);
                        const long keyrow0 = (row0 < MP) ? row0 : (MP + (long)(s - 2) * 192 + 128 + t);
                        if (isK) {
#pragma unroll
                            for (int j = 0; j < 4; ++j) SK[(keyrow0 + j) * 256 + c] = f2bf(v[j]);
                        } else {
                            uint2 pk; pk.x = pack2(v[0], v[1]); pk.y = pack2(v[2], v[3]);
                            *(uint2*)(SVT + (long)c * SROWS + keyrow0) = pk;
                        }
                        if (row0 < MP) {
                            if (t >= 16384 - 128) {
                                float* o = p->out + (isK ? O_PSK : O_PSV) + ((long)(jl * 2 + s) * 128 + (t - (16384 - 128))) * 256 + c;
#pragma unroll
                                for (int j = 0; j < 4; ++j) o[j * 256] = v[j];
                            }
                        } else {
                            float* o = p->out + (isK ? O_SSK : O_SSV) + ((long)(jl * 16 + (s - 2)) * 128 + 64 + t) * 256 + c;
#pragma unroll
                            for (int j = 0; j < 4; ++j) o[j * 256] = v[j];
                        }
                    }
    }
}
__device__ __forceinline__ void tile_lora(PP p, int jl, int which, int mt, int nt, char* smem) {
    f32x4 acc[4][4];
    const bf16_t* A = (const bf16_t*)(p->ws + A_LORA) + (long)mt * 128 * 256 + (which == 0 ? 0 : which == 1 ? 64 : 128);
    const int K = which == 2 ? 128 : 64;
    const bf16_t* Bt = (const bf16_t*)(p->ws + (which == 0 ? W_W2 : which == 1 ? W_A2 : W_G2)) + (long)nt * 128 * K;
    gemm_core(A, 256, Bt, K, K, smem, acc);
    EPI_IDX
    bf16_t* O = (bf16_t*)(p->ws + (which == 0 ? B_E : which == 1 ? B_AA : B_G));
    const float* bias = which == 0 ? p->in[22] + jl * 512 : p->in[24] + jl * 512;
    float bl[4];
#pragma unroll
    for (int ni = 0; ni < 4; ++ni) bl[ni] = bias[cbase_ + ni * 16];
#pragma unroll
    for (int mi = 0; mi < 4; ++mi)
#pragma unroll
        for (int ni = 0; ni < 4; ++ni)
#pragma unroll
            for (int j = 0; j < 4; ++j) {
                const int row = rbase_ + mi * 16 + j, col = cbase_ + ni * 16;
                float v = acc[mi][ni][j];
                if (which == 0) {
                    const float z = -(bl[ni] + v);
                    const float sp = z > 15.f ? z : __logf(1.f + __expf(z));
                    v = __expf(-sp - 0.5f);
                } else if (which == 1) {
                    v = sigmoidf_(bl[ni] + v);
                }
                O[(long)row * 512 + col] = f2bf(v);
            }
}
__device__ __forceinline__ void norm_phase(PP p, int l, int nsel, int first, int stride) {
    const int lane = TIDX & 63;
    const float* g = p->in[12] + (l * 3 + nsel) * 1024;
    int rg = first;
    if (rg >= MT / 4) return;
    f32x4 nx[4][4];
#define NORM_LOAD(RG) { const float* x_ = p->out + (long)(RG) * 4096; _Pragma("unroll") for (int r = 0; r < 4; ++r) _Pragma("unroll") for (int i = 0; i < 4; ++i) nx[r][i] = *(const f32x4*)(x_ + r * 1024 + i * 256 + lane * 4); }
    NORM_LOAD(rg)
    for (;;) {
        const int row = rg * 4;
        int s, t; seqinfo(row, s, t);
        const float* md = (const float*)(p->ws + WS_MODS) + (long)(l * 18 + s) * 9216;
        const float* sh = md + (nsel * 3) * 1024;
        const float* sc = md + (nsel * 3 + 1) * 1024;
        f32x4 v[4][4], ggv[4], s1v[4], s0v[4];
#pragma unroll
        for (int i = 0; i < 4; ++i) { const int c = i * 256 + lane * 4; ggv[i] = *(const f32x4*)(g + c); s1v[i] = *(const f32x4*)(sc + c); s0v[i] = *(const f32x4*)(sh + c); }
#pragma unroll
        for (int r = 0; r < 4; ++r)
#pragma unroll
            for (int i = 0; i < 4; ++i) v[r][i] = nx[r][i];
        const int rgn = rg + stride;
        if (rgn < MT / 4) NORM_LOAD(rgn)
        float ss[4];
#pragma unroll
        for (int r = 0; r < 4; ++r) {
            ss[r] = 0.f;
#pragma unroll
            for (int i = 0; i < 4; ++i) ss[r] += v[r][i][0] * v[r][i][0] + v[r][i][1] * v[r][i][1] + v[r][i][2] * v[r][i][2] + v[r][i][3] * v[r][i][3];
        }
#pragma unroll
        for (int o = 32; o >= 1; o >>= 1) {
            float t_[4];
#pragma unroll
            for (int r = 0; r < 4; ++r) t_[r] = __shfl_xor(ss[r], o);
#pragma unroll
            for (int r = 0; r < 4; ++r) ss[r] += t_[r];
        }
        bf16_t* h = (bf16_t*)(p->ws + WS_H) + (long)row * 1024;
#pragma unroll
        for (int i = 0; i < 4; ++i) {
            const f32x4 ga = ggv[i] * (s1v[i] + 1.f);
#pragma unroll
            for (int r = 0; r < 4; ++r) {
                const float rstd = rsqrtf(ss[r] * (1.0f / 1024.0f) + 1e-6f);
                const f32x4 o4 = v[r][i] * rstd * ga + s0v[i];
                uint2 o; o.x = pack2(o4[0], o4[1]); o.y = pack2(o4[2], o4[3]);
                *(uint2*)(h + r * 1024 + i * 256 + lane * 4) = o;
            }
        }
        if (rgn >= MT / 4) break;
        rg = rgn;
    }
}
__device__ __forceinline__ void final_norm_row(PP p, int row) {
    const int lane = TIDX & 63;
    float* x = p->out + (long)row * 1024;
    const float* g = p->in[36];
    float4 v[4];
    float ss = 0.f;
#pragma unroll
    for (int i = 0; i < 4; ++i) { v[i] = *(const float4*)(x + i * 256 + lane * 4); ss += v[i].x * v[i].x + v[i].y * v[i].y + v[i].z * v[i].z + v[i].w * v[i].w; }
    ss = wave_sum(ss);
    const float rstd = rsqrtf(ss * (1.0f / 1024.0f) + 1e-6f);
#pragma unroll
    for (int i = 0; i < 4; ++i) {
        const int c = i * 256 + lane * 4;
        const float4 gg = *(const float4*)(g + c);
        float4 o = make_float4(v[i].x * rstd * gg.x, v[i].y * rstd * gg.y, v[i].z * rstd * gg.z, v[i].w * rstd * gg.w);
        *(float4*)(x + c) = o;
    }
}

__device__ __forceinline__ void phase0(PP p, char* smem) {
    const int tid = TIDX;
    const long gtid = (long)blockIdx.x * NTHR + tid, gsz = (long)gridDim.x * NTHR;
    {
        const float4* xp = (const float4*)p->in[0]; const float4* xs = (const float4*)p->in[1];
        float4* o = (float4*)p->out;
        const long np = (long)MP * 256, ns = 1024L * 256;
        for (long i0 = gtid; i0 < np + ns; i0 += 4 * gsz) {
            f32x4 t4[4];
#pragma unroll
            for (int u = 0; u < 4; ++u) { const long i = i0 + u * gsz; t4[u] = (f32x4){0.f, 0.f, 0.f, 0.f}; if (i < np + ns) t4[u] = (i < np) ? *(const f32x4*)(xp + i) : *(const f32x4*)(xs + (i - np)); }
#pragma unroll
            for (int u = 0; u < 4; ++u) { const long i = i0 + u * gsz; if (i < np + ns) *(f32x4*)(o + i) = t4[u]; }
        }
    }
    for (long i = gtid; i < 16384L * 16; i += gsz) {
        const int pos = (int)(i >> 4), k = (int)(i & 15);
        const double f = exp(-(double)k / 16.0 * 9.210340371976184);
        const double ang = (double)pos * f;
        float* r = (float*)(p->ws + WS_ROPE);
        r[pos * 32 + k] = (float)cos(ang);
        r[pos * 32 + 16 + k] = (float)sin(ang);
    }
    for (long i = gtid; i < 2L * 2 * 16 * 64 * 256; i += gsz) {
        long r = i;
        const int c = (int)(r & 255); r >>= 8;
        const int row = (int)(r & 63); r >>= 6;
        const int sb = (int)(r & 15); r >>= 4;
        const int jl = (int)(r & 1); r >>= 1;
        const int kv = (int)r;
        const float* src = (kv ? p->in[7] : p->in[6]) + ((long)(jl * 16 + sb) * 128 + 64 + row) * 256 + c;
        p->out[(kv ? O_SSV : O_SSK) + ((long)(jl * 16 + sb) * 128 + row) * 256 + c] = *src;
    }
    {
        const int half = tid >> 8, th = tid & 255, kq = th >> 6, cl = th & 63;
        float* csm = (float*)(smem + half * HALF_LDS);
        for (int it = blockIdx.x * 2; it < 4 * 144; it += gridDim.x * 2) {
            const int item = it + half;
            const int l = item / 144, cc = item % 144;
            const int jcol = cc * 64 + cl;
            float acc[18];
#pragma unroll
            for (int s = 0; s < 18; ++s) acc[s] = 0.f;
            const float* w = p->in[10] + (long)l * 1024 * 9216 + jcol;
            for (int kc = 0; kc < 4; ++kc) {
                const int kb = kq * 256 + kc * 64;
                __syncthreads();
#pragma unroll
                for (int s = 0; s < 18; ++s) {
                    const float c = (s < 2) ? p->in[8][s * 1024 + kb + cl] : p->in[9][(s - 2) * 1024 + kb + cl];
                    csm[(kq * 18 + s) * 64 + cl] = c / (1.f + __expf(-c));
                }
                __syncthreads();
                for (int k0 = 0; k0 < 64; k0 += 16) {
                    float wv[16];
#pragma unroll
                    for (int u = 0; u < 16; ++u) wv[u] = w[(long)(kb + k0 + u) * 9216];
#pragma unroll
                    for (int u = 0; u < 16; ++u) {
#pragma unroll
                        for (int s = 0; s < 18; ++s) acc[s] += csm[(kq * 18 + s) * 64 + k0 + u] * wv[u];
                    }
                }
            }
            __syncthreads();
#pragma unroll
            for (int s = 0; s < 18; ++s) csm[(kq * 18 + s) * 64 + cl] = acc[s];
            __syncthreads();
            if (kq == 0) {
                const float b = p->in[11][l * 9216 + jcol];
                float* mods = (float*)(p->ws + WS_MODS);
#pragma unroll
                for (int s = 0; s < 18; ++s)
                    mods[(long)(l * 18 + s) * 9216 + jcol] = ((csm[s * 64 + cl] + csm[(18 + s) * 64 + cl]) + (csm[(36 + s) * 64 + cl] + csm[(54 + s) * 64 + cl])) + b;
            }
        }
    }
}

__device__ __forceinline__ void unpack4(uint2 u, float (&v)[4]) { v[0] = bf2f(u.x & 0xffff); v[1] = bf2f(u.x >> 16); v[2] = bf2f(u.y & 0xffff); v[3] = bf2f(u.y >> 16); }
__device__ __forceinline__ void even_prep_row(PP p, int jl, int row) {
    const int lane = TIDX & 63;
    int s, t; seqinfo(row, s, t);
    const bool isP = row < MP;
    const int pos = isP ? t : 4096 + t;
    const long keyrow = isP ? row : (MP + (long)(s - 2) * 4160 + 4096 + t);
    const bf16_t* pr = (const bf16_t*)(p->ws + WS_BIG) + (long)row * 3072;
    uint2 cqu[3], ckvu, cu[7], pu[7];
    float4 gq[3], gkv, muv[7], sh4[7];
    const float* gqp = p->in[17] + jl * 768;
    const float* mu = p->in[21] + jl * 1792;
    const bf16_t* prw = pr + 1056;
    const bf16_t* pv = pr - 3072 + 1056;
    const float* sh0 = p->in[5] + (long)(jl * 16 + (s - 2)) * 1792;
#pragma unroll
    for (int i = 0; i < 3; ++i) { cqu[i] = *(const uint2*)(pr + i * 256 + lane * 4); gq[i] = *(const float4*)(gqp + i * 256 + lane * 4); }
    ckvu = *(const uint2*)(pr + 768 + lane * 4);
    gkv = *(const float4*)(p->in[18] + jl * 256 + lane * 4);
    const float* rope = (const float*)(p->ws + WS_ROPE);
    float cs = 0.f, sn = 0.f, x1 = 0.f, x2 = 0.f;
    if (lane < 16) { cs = rope[pos * 32 + lane]; sn = rope[pos * 32 + 16 + lane]; x1 = bf2f(pr[1024 + lane]); x2 = bf2f(pr[1024 + 16 + lane]); }
#pragma unroll
    for (int i = 0; i < 7; ++i) {
        const int c = i * 256 + lane * 4;
        cu[i] = *(const uint2*)(prw + c);
        muv[i] = *(const float4*)(mu + c);
        pu[i] = make_uint2(0u, 0u); sh4[i] = make_float4(0.f, 0.f, 0.f, 0.f);
        if (t > 0) pu[i] = *(const uint2*)(pv + c);
        else if (!isP) sh4[i] = *(const float4*)(sh0 + c);
    }
    {
        float v[3][4]; float ss = 0.f;
#pragma unroll
        for (int i = 0; i < 3; ++i) { unpack4(cqu[i], v[i]); ss += v[i][0] * v[i][0] + v[i][1] * v[i][1] + v[i][2] * v[i][2] + v[i][3] * v[i][3]; }
        float v2[4]; unpack4(ckvu, v2);
        float ss2 = v2[0] * v2[0] + v2[1] * v2[1] + v2[2] * v2[2] + v2[3] * v2[3];
#pragma unroll
        for (int o = 32; o >= 1; o >>= 1) { const float a0 = __shfl_xor(ss, o), a1 = __shfl_xor(ss2, o); ss += a0; ss2 += a1; }
        const float rstd = rsqrtf(ss * (1.0f / 768.0f) + 1e-6f);
        bf16_t* o = (bf16_t*)(p->ws + A_CQN) + (long)row * 768;
#pragma unroll
        for (int i = 0; i < 3; ++i) {
            uint2 w;
            w.x = pack2(v[i][0] * rstd * gq[i].x, v[i][1] * rstd * gq[i].y);
            w.y = pack2(v[i][2] * rstd * gq[i].z, v[i][3] * rstd * gq[i].w);
            *(uint2*)(o + i * 256 + lane * 4) = w;
        }
        const float rstd2 = rsqrtf(ss2 * (1.0f / 256.0f) + 1e-6f);
        const int c = lane * 4;
        float4 ov = make_float4(v2[0] * rstd2 * gkv.x, v2[1] * rstd2 * gkv.y, v2[2] * rstd2 * gkv.z, v2[3] * rstd2 * gkv.w);
        float* op = isP ? p->out + O_PCKV + ((long)(jl * 2 + s) * 16384 + t) * 256 + c
                        : p->out + O_SCKV + ((long)(jl * 16 + (s - 2)) * 64 + t) * 256 + c;
        *(float4*)op = ov;
        uint2 w; w.x = pack2(ov.x, ov.y); w.y = pack2(ov.z, ov.w);
        *(uint2*)((bf16_t*)(p->ws + A_CKV) + keyrow * 256 + c) = w;
    }
    if (lane < 16) {
        const float o1 = x1 * cs - x2 * sn, o2 = x1 * sn + x2 * cs;
        float* op = isP ? p->out + O_PKR + ((long)(jl * 2 + s) * 16384 + t) * 32
                        : p->out + O_SKR + ((long)(jl * 16 + (s - 2)) * 64 + t) * 32;
        op[lane] = o1; op[16 + lane] = o2;
        bf16_t* kr = (bf16_t*)(p->ws + A_KR) + keyrow * 32;
        kr[lane] = f2bf(o1); kr[16 + lane] = f2bf(o2);
    }
    {
        const int tlast = isP ? 16383 : 63;
        float* sho = isP ? p->out + O_PSH + (long)(jl * 2 + s) * 1792 : p->out + O_SSH + (long)(jl * 16 + (s - 2)) * 1792;
        bf16_t* R = (bf16_t*)(p->ws + A_R) + (long)row * 512;
        bf16_t* Kb = (bf16_t*)(p->ws + A_K) + (long)row * 512;
        bf16_t* Vb = (bf16_t*)(p->ws + A_V) + (long)row * 512;
        bf16_t* L = (bf16_t*)(p->ws + A_LORA) + (long)row * 256;
#pragma unroll
        for (int i = 0; i < 7; ++i) {
            const int c = i * 256 + lane * 4;
            float cur[4], prev[4];
            unpack4(cu[i], cur);
            if (t > 0) unpack4(pu[i], prev);
            else { prev[0] = sh4[i].x; prev[1] = sh4[i].y; prev[2] = sh4[i].z; prev[3] = sh4[i].w; }
            float pm[4];
            pm[0] = cur[0] + (prev[0] - cur[0]) * muv[i].x; pm[1] = cur[1] + (prev[1] - cur[1]) * muv[i].y;
            pm[2] = cur[2] + (prev[2] - cur[2]) * muv[i].z; pm[3] = cur[3] + (prev[3] - cur[3]) * muv[i].w;
            if (t == tlast) *(float4*)(sho + c) = make_float4(cur[0], cur[1], cur[2], cur[3]);
            bf16_t* dst;
            if (c < 512) dst = R + c;
            else if (c < 576) { dst = L + (c - 512); pm[0] = tanhf(pm[0]); pm[1] = tanhf(pm[1]); pm[2] = tanhf(pm[2]); pm[3] = tanhf(pm[3]); }
            else if (c < 1088) dst = Kb + (c - 576);
            else if (c < 1600) dst = Vb + (c - 1088);
            else if (c < 1664) dst = L + 64 + (c - 1600);
            else { dst = L + 128 + (c - 1664); pm[0] = sigmoidf_(pm[0]); pm[1] = sigmoidf_(pm[1]); pm[2] = sigmoidf_(pm[2]); pm[3] = sigmoidf_(pm[3]); }
            uint2 w; w.x = pack2(pm[0], pm[1]); w.y = pack2(pm[2], pm[3]);
            *(uint2*)dst = w;
        }
    }
}

struct AttnW { const bf16_t* q1; const bf16_t* q2; bf16_t* o; long qg, og; int n64b, n64s, ngrp; const float* sinkp; int hq0; int dist0; };
struct AttnKV { const bf16_t* k1; long ldk1; const bf16_t* k2; long ldk2; const bf16_t* vt; long ldvt; int nkt; long ldq; long ldo; int has_sink; };
__device__ __forceinline__ float max3f(float a, float b, float c) { float r; asm("v_max3_f32 %0, %1, %2, %3" : "=v"(r) : "v"(a), "v"(b), "v"(c)); return r; }
template <int DQK>
__device__ __forceinline__ void attn_block(const AttnKV& a, const AttnW& gw, char* smem) {
    const int tid = TIDX, wv = tid >> 6, g = wv >> 1, wh = wv & 1, lane = tid & 63, lr = lane & 15, lq = lane >> 4;
    constexpr int KS = DQK / 32, KROWB = DQK * 2 + 32  , CPR = DQK / 8, VROWB = 272;
    constexpr int KBYTES = 128 * KROWB, VBYTES = 64 * VROWB, BUFB = KBYTES + VBYTES;
    static_assert(2 * BUFB <= SMEM_BYTES, "attention LDS");
    const int n64 = g < gw.ngrp ? gw.n64b + g * gw.n64s : 0;
    const float slope2 = a.has_sink ? exp2f(-0.5f * (float)(gw.hq0 + g + 1)) * 1.4426950408889634f : 0.f;
    const float sink2 = a.has_sink ? gw.sinkp[g] * 1.4426950408889634f : 0.f;
    const int dist0 = gw.dist0;
    const bool active = n64 > 0;
    bf16x8 qf[2][KS];
#pragma unroll
    for (int qt = 0; qt < 2; ++qt)
#pragma unroll
        for (int ks = 0; ks < KS; ++ks) qf[qt][ks] = (bf16x8){0, 0, 0, 0, 0, 0, 0, 0};
    if (active) {
#pragma unroll
        for (int qt = 0; qt < 2; ++qt) {
            const long r = wh * 32 + qt * 16 + lr;
            const bf16_t* qp = gw.q1 + g * gw.qg + r * a.ldq;
            qf[qt][0] = *(const bf16x8*)(qp + lq * 8);
            qf[qt][1] = *(const bf16x8*)(qp + 32 + lq * 8);
            if (KS == 3) qf[qt][KS - 1] = *(const bf16x8*)(gw.q2 + g * gw.qg + r * a.ldq + lq * 8);
        }
    }
    f32x4 ot[2][4];
    float m[2], l[2];
#pragma unroll
    for (int qt = 0; qt < 2; ++qt) {
#pragma unroll
        for (int i = 0; i < 4; ++i) ot[qt][i] = (f32x4){0.f, 0.f, 0.f, 0.f};
        m[qt] = a.has_sink ? sink2 : -1e30f; l[qt] = a.has_sink ? 1.f : 0.f;
    }
    constexpr int NKC = 128 * CPR / 512;
    u32x4 kregA[NKC], vregA[2];
    const bf16_t* kptr[NKC]; int kstr[NKC]; int klds[NKC];
    const bf16_t* vptr[2]; int vlds[2];
#pragma unroll
    for (int i_ = 0; i_ < NKC; ++i_) {
        const int id = tid + i_ * 512; const int r = id / CPR, c = id % CPR;
        if (c < 8) { kptr[i_] = a.k1 + (long)r * a.ldk1 + c * 8; kstr[i_] = 128 * (int)a.ldk1; }
        else { kptr[i_] = a.k2 + (long)r * a.ldk2 + (c - 8) * 8; kstr[i_] = 128 * (int)a.ldk2; }
        klds[i_] = r * KROWB + c * 16;
    }
#pragma unroll
    for (int i_ = 0; i_ < 2; ++i_) { const int id = tid + i_ * 512; const int d = id >> 4, c = id & 15; vptr[i_] = a.vt + (long)d * a.ldvt + c * 8; vlds[i_] = KBYTES + d * VROWB + c * 16; }
#define ATTN_PF(KT, KR_, VR_) do { \
        _Pragma("unroll") for (int i_ = 0; i_ < NKC; ++i_) { KR_[i_] = *(const u32x4*)kptr[i_]; kptr[i_] += kstr[i_]; } \
        _Pragma("unroll") for (int i_ = 0; i_ < 2; ++i_) { VR_[i_] = *(const u32x4*)vptr[i_]; vptr[i_] += 128; } } while (0)
#define ATTN_ST(BUF, KR_, VR_) do { char* kb_ = smem + (BUF) * BUFB; \
        _Pragma("unroll") for (int i_ = 0; i_ < NKC; ++i_) *(u32x4*)(kb_ + klds[i_]) = KR_[i_]; \
        _Pragma("unroll") for (int i_ = 0; i_ < 2; ++i_) *(u32x4*)(kb_ + vlds[i_]) = VR_[i_]; } while (0)
    __syncthreads();
    ATTN_PF(0, kregA, vregA);
    ATTN_ST(0, kregA, vregA);
    if (a.nkt > 1) ATTN_PF(1, kregA, vregA);
    __syncthreads();
#define ATTN_ITER(kt) { \
        if ((kt) + 1 < a.nkt) ATTN_ST(((kt) + 1) & 1, kregA, vregA); \
        if ((kt) + 2 < a.nkt) ATTN_PF((kt) + 2, kregA, vregA); \
        attn_tile((kt)); \
        __syncthreads(); }
    auto attn_tile = [&](int kt) {
        const int hc = n64 - 2 * kt;
        if (hc > 0) {
            const char* Ks = smem + (kt & 1) * BUFB;
            const char* Vs = Ks + KBYTES;
            f32x4 st[2][8];
#pragma unroll
            for (int nt = 0; nt < 8; ++nt) {
                if (nt < 4 || hc >= 2) {
                    st[0][nt] = (f32x4){0.f, 0.f, 0.f, 0.f}; st[1][nt] = (f32x4){0.f, 0.f, 0.f, 0.f};
#pragma unroll
                    for (int ks = 0; ks < KS; ++ks) {
                        const bf16x8 kf = *(const bf16x8*)(Ks + (nt * 16 + lr) * KROWB + (ks * 4 + lq) * 16);
                        st[0][nt] = __builtin_amdgcn_mfma_f32_16x16x32_bf16(kf, qf[0][ks], st[0][nt], 0, 0, 0);
                        st[1][nt] = __builtin_amdgcn_mfma_f32_16x16x32_bf16(kf, qf[1][ks], st[1][nt], 0, 0, 0);
                    }
                } else {
                    st[0][nt] = (f32x4){-1e30f, -1e30f, -1e30f, -1e30f}; st[1][nt] = st[0][nt];
                }
            }
#pragma unroll
            for (int qt = 0; qt < 2; ++qt) {
                if (slope2 != 0.f) {
                    const int qd = wh * 32 + qt * 16 + lr + dist0 - kt * 128 - lq * 4;
#pragma unroll
                    for (int nt = 0; nt < 8; ++nt)
#pragma unroll
                        for (int jj = 0; jj < 4; ++jj) st[qt][nt][jj] -= slope2 * fabsf((float)(qd - nt * 16 - jj));
                }
                float mxa = max3f(st[qt][0][0], st[qt][0][1], st[qt][0][2]), mxb = max3f(st[qt][0][3], st[qt][1][0], st[qt][1][1]);
                mxa = max3f(mxa, st[qt][1][2], st[qt][1][3]);
#pragma unroll
                for (int nt = 2; nt < 8; nt += 2) {
                    mxb = max3f(mxb, st[qt][nt][0], st[qt][nt][1]); mxa = max3f(mxa, st[qt][nt][2], st[qt][nt][3]);
                    mxb = max3f(mxb, st[qt][nt + 1][0], st[qt][nt + 1][1]); mxa = max3f(mxa, st[qt][nt + 1][2], st[qt][nt + 1][3]);
                }
                float mx = fmaxf(mxa, mxb);
                mx = fmaxf(mx, __shfl_xor(mx, 16)); mx = fmaxf(mx, __shfl_xor(mx, 32));
                const float mnew = fmaxf(m[qt], mx);
                const float alpha = __builtin_amdgcn_exp2f(m[qt] - mnew);
                m[qt] = mnew;
                f32x4 rs4 = {0.f, 0.f, 0.f, 0.f};
                const f32x4 negm4 = {-mnew, -mnew, -mnew, -mnew};
#pragma unroll
                for (int nt = 0; nt < 8; ++nt) {
                    const f32x4 d4 = st[qt][nt] + negm4;
                    f32x4 e4;
                    e4[0] = __builtin_amdgcn_exp2f(d4[0]); e4[1] = __builtin_amdgcn_exp2f(d4[1]); e4[2] = __builtin_amdgcn_exp2f(d4[2]); e4[3] = __builtin_amdgcn_exp2f(d4[3]);
                    st[qt][nt] = e4; rs4 += e4;
                }
                float rs = (rs4[0] + rs4[1]) + (rs4[2] + rs4[3]);
                rs += __shfl_xor(rs, 16); rs += __shfl_xor(rs, 32);
                l[qt] = l[qt] * alpha + rs;
                if (__builtin_amdgcn_ballot_w64(alpha != 1.0f) != 0ull) {
#pragma unroll
                    for (int dt = 0; dt < 4; ++dt) ot[qt][dt] *= alpha;
                }
            }
#pragma unroll
            for (int k2 = 0; k2 < 4; ++k2) {
                if (k2 < 2 || hc >= 2) {
                    bf16x8 pf[2];
#pragma unroll
                    for (int qt = 0; qt < 2; ++qt) {
                        const f32x8 p8 = __builtin_shufflevector(st[qt][2 * k2], st[qt][2 * k2 + 1], 0, 1, 2, 3, 4, 5, 6, 7);
                        pf[qt] = __builtin_bit_cast(bf16x8, __builtin_convertvector(p8, bf16v8_t));
                    }
#pragma unroll
                    for (int dt = 0; dt < 4; ++dt) {
                        const char* vrow = Vs + (dt * 16 + lr) * VROWB + lq * 8;
                        const uint2 v0 = *(const uint2*)(vrow + (2 * k2) * 32), v1 = *(const uint2*)(vrow + (2 * k2 + 1) * 32);
                        u32x4 vw; vw.x = v0.x; vw.y = v0.y; vw.z = v1.x; vw.w = v1.y;
                        const bf16x8 vf = __builtin_bit_cast(bf16x8, vw);
                        ot[0][dt] = __builtin_amdgcn_mfma_f32_16x16x32_bf16(vf, pf[0], ot[0][dt], 0, 0, 0);
                        ot[1][dt] = __builtin_amdgcn_mfma_f32_16x16x32_bf16(vf, pf[1], ot[1][dt], 0, 0, 0);
                    }
                }
            }
        }
    };
    for (int kt = 0; kt < a.nkt; ++kt) ATTN_ITER(kt)
    if (active) {
#pragma unroll
        for (int qt = 0; qt < 2; ++qt) {
            const float inv = 1.0f / l[qt];
            bf16_t* orow = gw.o + g * gw.og + (long)(wh * 32 + qt * 16 + lr) * a.ldo + lq * 4;
#pragma unroll
            for (int dt = 0; dt < 4; ++dt) {
                uint2 w; w.x = pack2(ot[qt][dt][0] * inv, ot[qt][dt][1] * inv); w.y = pack2(ot[qt][dt][2] * inv, ot[qt][dt][3] * inv);
                *(uint2*)(orow + dt * 16) = w;
            }
        }
    }
}

__device__ __forceinline__ void mla_item(PP p, int item, char* smem) {
    AttnKV a; AttnW w;
    const bf16_t* Q = (const bf16_t*)(p->ws + B_Q);
    const bf16_t* KN = (const bf16_t*)(p->ws + C_KN);
    const bf16_t* KR = (const bf16_t*)(p->ws + A_KR);
    const bf16_t* VT = (const bf16_t*)(p->ws + C_VT);
    bf16_t* MIX = (bf16_t*)(p->ws + WS_H);
    long row0, key0; int hd, nkt;
    w.dist0 = 0; w.sinkp = nullptr; w.hq0 = 0;
    if (item >= 1024) {
        const int si = item - 1024; const int sb = si >> 3; hd = si & 7; row0 = MP + sb * 64; key0 = MP + (long)sb * 4160; nkt = 33;
        w.n64b = 65; w.n64s = 0; w.ngrp = 1;
    } else {
        const int it = item; const int cq = 63 - (it >> 4); const int b = (it >> 3) & 1; hd = it & 7;
        row0 = (long)b * 16384 + cq * 256; key0 = (long)b * 16384; nkt = 2 * cq + 2;
        w.n64b = 4 * cq + 1; w.n64s = 1; w.ngrp = 4;
    }
    w.q1 = Q + row0 * 768 + hd * 64; w.q2 = Q + row0 * 768 + 512 + hd * 32; w.o = MIX + row0 * 1024 + hd * 64;
    w.qg = 64 * 768; w.og = 64 * 1024;
    a.ldq = 768; a.ldo = 1024;
    a.k1 = KN + key0 * 512 + hd * 64; a.ldk1 = 512; a.k2 = KR + key0 * 32; a.ldk2 = 32;
    a.vt = VT + (long)(hd * 64) * KROWS + key0; a.ldvt = KROWS;
    a.nkt = nkt; a.has_sink = 0;
    attn_block<96>(a, w, smem);
}
__device__ __forceinline__ void swa_item(PP p, int jl, int item, char* smem) {
    AttnKV a; AttnW w;
    const bf16_t* Q = (const bf16_t*)(p->ws + B_Q);
    const bf16_t* SK = (const bf16_t*)(p->ws + B_SWK);
    const bf16_t* SVT = (const bf16_t*)(p->ws + B_SWVT);
    bf16_t* MIX = (bf16_t*)(p->ws + WS_H);
    long row0, key0; int kvh, nkt, dist0;
    if (item < 2048) { const int b = item >> 10; const int c = (item >> 2) & 255; kvh = item & 3; const int ks = (c >= 2 ? c - 2 : 0); row0 = (long)b * 16384 + c * 64; key0 = (long)b * 16384 + ks * 64; nkt = c + 1 - ks; dist0 = (c - ks) * 64; }
    else { const int it = item - 2048; const int sb = it >> 2; kvh = it & 3; row0 = MP + sb * 64; key0 = MP + (long)sb * 192; nkt = 3; dist0 = 128; }
    const int hq0 = kvh * 4;
    w.q1 = Q + row0 * 1024 + hq0 * 64; w.q2 = nullptr; w.o = MIX + row0 * 1024 + hq0 * 64;
    w.qg = 64; w.og = 64; w.dist0 = dist0;
    w.n64b = nkt; w.n64s = 0; w.ngrp = 4; w.sinkp = p->in[35] + jl * 16 + hq0; w.hq0 = hq0;
    a.ldq = 1024; a.ldo = 1024;
    a.k1 = SK + key0 * 256 + kvh * 64; a.ldk1 = 256; a.k2 = nullptr; a.ldk2 = 0;
    a.vt = SVT + (long)(kvh * 64) * SROWS + key0; a.ldvt = SROWS;
    a.nkt = (nkt + 1) >> 1; a.has_sink = 1;
    attn_block<64>(a, w, smem);
}

__device__ __forceinline__ void scan_task(PP p, int jl, int task, float* wl) {
    const int lane = TIDX & 63;
    const bool isPt = (task >= 2048 && task < 4096);
    const bool isS = task >= 4096;
    int hd, row0, nsteps, sb = 0, ctask = 0;
    if (!isS) { ctask = task & 2047; const int sh = ctask >> 7, c = ctask & 127; const int b = sh >> 3; hd = sh & 7; row0 = b * 16384 + c * 128; nsteps = 128; }
    else { const int t2 = task - 4096; sb = t2 >> 3; hd = t2 & 7; row0 = MP + sb * 64; nsteps = 64; }
    f32x2 U[32];
    if (isS) {
        const float* s0 = p->in[4] + ((long)(jl * 16 + sb) * 8 + hd) * 4096 + lane * 64;
#pragma unroll
        for (int jj = 0; jj < 32; ++jj) U[jj] = *(const f32x2*)(s0 + 2 * jj);
    } else if (isPt) {
#pragma unroll
        for (int jj = 0; jj < 32; ++jj) U[jj] = (f32x2){(2 * jj == lane) ? 1.f : 0.f, (2 * jj + 1 == lane) ? 1.f : 0.f};
    } else {
#pragma unroll
        for (int jj = 0; jj < 32; ++jj) U[jj] = (f32x2){0.f, 0.f};
    }
    const int col = hd * 64 + lane;
    const float kkw = p->in[27][jl * 512 + col], kaw = p->in[28][jl * 512 + col];
    const bf16_t* E = (const bf16_t*)(p->ws + B_E);
    const bf16_t* AA = (const bf16_t*)(p->ws + B_AA);
    const bf16_t* R = (const bf16_t*)(p->ws + A_R);
    const bf16_t* Kb = (const bf16_t*)(p->ws + A_K);
    const bf16_t* Vb = (const bf16_t*)(p->ws + A_V);
    bf16_t* MIX = (bf16_t*)(p->ws + WS_H);
    bf16_t* QT = (bf16_t*)(p->ws + A_QT);
    const float vmul = isPt ? 0.f : 1.f;
    bf16_t ne[4], na[4], nk[4], nr[4], nv[4];
#define SCANT_LOAD(T0) { _Pragma("unroll") for (int st = 0; st < 4; ++st) { const long idx = (long)(row0 + (T0) + st) * 512 + col; \
        ne[st] = E[idx]; na[st] = AA[idx]; nk[st] = Kb[idx]; nr[st] = R[idx]; nv[st] = Vb[idx]; } }
    SCANT_LOAD(0)
    for (int t0 = 0; t0 < nsteps; t0 += 4) {
        {
            float e_[4], a_[4], k_[4], r_[4], v_[4], ss[4];
#pragma unroll
            for (int st = 0; st < 4; ++st) {
                e_[st] = bf2f(ne[st]); a_[st] = bf2f(na[st]); k_[st] = bf2f(nk[st]); r_[st] = bf2f(nr[st]); v_[st] = bf2f(nv[st]);
                const float kkv = k_[st] * kkw; ss[st] = kkv * kkv;
            }
            if (t0 + 4 < nsteps) SCANT_LOAD(t0 + 4)
#pragma unroll
            for (int o = 32; o >= 1; o >>= 1) {
                float t_[4];
#pragma unroll
                for (int st = 0; st < 4; ++st) t_[st] = __shfl_xor(ss[st], o);
#pragma unroll
                for (int st = 0; st < 4; ++st) ss[st] += t_[st];
            }
#pragma unroll
            for (int st = 0; st < 4; ++st) {
                const float kkn = k_[st] * kkw * __builtin_amdgcn_rsqf(fmaxf(ss[st], 1e-24f));
                float* q = wl + st * 384;
                q[lane] = __expf(-e_[st]);
                q[64 + lane] = -kkn;
                q[128 + lane] = kkn * a_[st];
                q[192 + lane] = k_[st] * (1.f + (a_[st] - 1.f) * kaw);
                q[256 + lane] = r_[st];
                q[320 + lane] = v_[st] * vmul;
            }
        }
        WAVE_SYNC();
#pragma unroll 1
        for (int st = 0; st < 4; ++st) {
            const float* q = wl + st * 384;
            const float vi = q[320 + lane];
            const f32x4* Wq = (const f32x4*)q;
            const long orow = (long)(row0 + t0 + st);
            f32x2 sa0 = {0.f, 0.f}, sa1 = {0.f, 0.f};
#pragma unroll
            for (int h = 0; h < 2; ++h) {
                f32x4 t[8];
#pragma unroll
                for (int i = 0; i < 8; ++i) t[i] = Wq[16 + h * 8 + i];
#pragma unroll
                for (int i = 0; i < 8; ++i) { sa0 += U[h * 16 + 2 * i] * t[i].xy; sa1 += U[h * 16 + 2 * i + 1] * t[i].zw; }
            }
            const float sa = (sa0.x + sa0.y) + (sa1.x + sa1.y);
            f32x2 y0 = {0.f, 0.f}, y1 = {0.f, 0.f};
#pragma unroll
            for (int qd = 0; qd < 4; ++qd) {
                f32x4 tw[4], tb[4], tk[4], tr[4];
#pragma unroll
                for (int i = 0; i < 4; ++i) { tw[i] = Wq[qd * 4 + i]; tb[i] = Wq[32 + qd * 4 + i]; tk[i] = Wq[48 + qd * 4 + i]; tr[i] = Wq[64 + qd * 4 + i]; }
#pragma unroll
                for (int i = 0; i < 4; ++i) {
                    const int jj = qd * 8 + 2 * i;
                    U[jj] = U[jj] * tw[i].xy + (tb[i].xy * sa + tk[i].xy * vi);
                    U[jj + 1] = U[jj + 1] * tw[i].zw + (tb[i].zw * sa + tk[i].zw * vi);
                    y0 += U[jj] * tr[i].xy; y1 += U[jj + 1] * tr[i].zw;
                }
            }
            const bf16_t yo = f2bf((y0.x + y0.y) + (y1.x + y1.y));
            if (isPt) QT[orow * 512 + col] = yo;
            else MIX[orow * 1024 + 512 + col] = yo;
        }
        WAVE_SYNC();
    }
    if (isS) {
        float* So = p->out + O_SRW + ((long)(jl * 16 + sb) * 8 + hd) * 4096 + lane * 64;
#pragma unroll
        for (int jj = 0; jj < 32; ++jj) *(f32x2*)(So + 2 * jj) = U[jj];
    } else if (isPt) {
        bf16_t* Pb = (bf16_t*)(p->ws + B_PB) + (long)ctask * 4096 + lane * 64;
#pragma unroll
        for (int jj = 0; jj < 32; ++jj) *(uint32_t*)(Pb + 2 * jj) = pack2(U[jj].x, U[jj].y);
    } else {
        float* Ub = (float*)(p->ws + A_U) + (long)ctask * 4096 + lane * 64;
#pragma unroll
        for (int jj = 0; jj < 32; ++jj) *(f32x2*)(Ub + 2 * jj) = U[jj];
    }
}
__device__ __forceinline__ void scan_fused(PP p, int jl, int ctask, float* wl) {
    const int lane = TIDX & 63;
    const int sh = ctask >> 7, c = ctask & 127, b = sh >> 3, hd = sh & 7;
    const int row0 = b * 16384 + c * 128;
    f32x2 U[32], Pm[32];
#pragma unroll
    for (int jj = 0; jj < 32; ++jj) { U[jj] = (f32x2){0.f, 0.f}; Pm[jj] = (f32x2){(2 * jj == lane) ? 1.f : 0.f, (2 * jj + 1 == lane) ? 1.f : 0.f}; }
    const int col = hd * 64 + lane;
    const float kkw = p->in[27][jl * 512 + col], kaw = p->in[28][jl * 512 + col];
    const bf16_t* E = (const bf16_t*)(p->ws + B_E);
    const bf16_t* AA = (const bf16_t*)(p->ws + B_AA);
    const bf16_t* R = (const bf16_t*)(p->ws + A_R);
    const bf16_t* Kb = (const bf16_t*)(p->ws + A_K);
    const bf16_t* Vb = (const bf16_t*)(p->ws + A_V);
    bf16_t* MIX = (bf16_t*)(p->ws + WS_H);
    bf16_t* QT = (bf16_t*)(p->ws + A_QT);
    bf16_t ne[4], na[4], nk[4], nr[4], nv[4];
#define SCAN_LOAD(T0) { _Pragma("unroll") for (int st = 0; st < 4; ++st) { const long idx = (long)(row0 + (T0) + st) * 512 + col; \
        ne[st] = E[idx]; na[st] = AA[idx]; nk[st] = Kb[idx]; nr[st] = R[idx]; nv[st] = Vb[idx]; } }
    SCAN_LOAD(0)
    for (int t0 = 0; t0 < 128; t0 += 4) {
        {
            float e_[4], a_[4], k_[4], r_[4], v_[4], ss[4];
#pragma unroll
            for (int st = 0; st < 4; ++st) {
                e_[st] = bf2f(ne[st]); a_[st] = bf2f(na[st]); k_[st] = bf2f(nk[st]); r_[st] = bf2f(nr[st]); v_[st] = bf2f(nv[st]);
                const float kkv = k_[st] * kkw; ss[st] = kkv * kkv;
            }
            if (t0 + 4 < 128) SCAN_LOAD(t0 + 4)
#pragma unroll
            for (int o = 32; o >= 1; o >>= 1) {
                float t_[4];
#pragma unroll
                for (int st = 0; st < 4; ++st) t_[st] = __shfl_xor(ss[st], o);
#pragma unroll
                for (int st = 0; st < 4; ++st) ss[st] += t_[st];
            }
#pragma unroll
            for (int st = 0; st < 4; ++st) {
                const float kkn = k_[st] * kkw * __builtin_amdgcn_rsqf(fmaxf(ss[st], 1e-24f));
                float* q = wl + st * 384;
                q[lane] = __expf(-e_[st]);
                q[64 + lane] = -kkn;
                q[128 + lane] = kkn * a_[st];
                q[192 + lane] = k_[st] * (1.f + (a_[st] - 1.f) * kaw);
                q[256 + lane] = r_[st];
                q[320 + lane] = v_[st];
            }
        }
        WAVE_SYNC();
#pragma unroll 1
        for (int st = 0; st < 4; ++st) {
            const float* q = wl + st * 384;
            const float vi = q[320 + lane];
            const f32x4* Wq = (const f32x4*)q;
            const long orow = (long)(row0 + t0 + st);
            f32x2 sa0 = {0.f, 0.f}, sa1 = {0.f, 0.f}, sp0 = {0.f, 0.f}, sp1 = {0.f, 0.f};
#pragma unroll
            for (int h = 0; h < 2; ++h) {
                f32x4 t[8];
#pragma unroll
                for (int i = 0; i < 8; ++i) t[i] = Wq[16 + h * 8 + i];
#pragma unroll
                for (int i = 0; i < 8; ++i) {
                    sa0 += U[h * 16 + 2 * i] * t[i].xy; sa1 += U[h * 16 + 2 * i + 1] * t[i].zw;
                    sp0 += Pm[h * 16 + 2 * i] * t[i].xy; sp1 += Pm[h * 16 + 2 * i + 1] * t[i].zw;
                }
            }
            const float sa = (sa0.x + sa0.y) + (sa1.x + sa1.y), sp = (sp0.x + sp0.y) + (sp1.x + sp1.y);
            f32x2 y0 = {0.f, 0.f}, y1 = {0.f, 0.f}, z0 = {0.f, 0.f}, z1 = {0.f, 0.f};
#pragma unroll
            for (int qd = 0; qd < 8; ++qd) {
                f32x4 tw[2], tb[2], tk[2], tr[2];
#pragma unroll
                for (int i = 0; i < 2; ++i) { tw[i] = Wq[qd * 2 + i]; tb[i] = Wq[32 + qd * 2 + i]; tk[i] = Wq[48 + qd * 2 + i]; tr[i] = Wq[64 + qd * 2 + i]; }
#pragma unroll
                for (int i = 0; i < 2; ++i) {
                    const int jj = qd * 4 + 2 * i;
                    U[jj] = U[jj] * tw[i].xy + (tb[i].xy * sa + tk[i].xy * vi);
                    U[jj + 1] = U[jj + 1] * tw[i].zw + (tb[i].zw * sa + tk[i].zw * vi);
                    Pm[jj] = Pm[jj] * tw[i].xy + tb[i].xy * sp;
                    Pm[jj + 1] = Pm[jj + 1] * tw[i].zw + tb[i].zw * sp;
                    y0 += U[jj] * tr[i].xy; y1 += U[jj + 1] * tr[i].zw;
                    z0 += Pm[jj] * tr[i].xy; z1 += Pm[jj + 1] * tr[i].zw;
                }
            }
            MIX[orow * 1024 + 512 + col] = f2bf((y0.x + y0.y) + (y1.x + y1.y));
            QT[orow * 512 + col] = f2bf((z0.x + z0.y) + (z1.x + z1.y));
        }
        WAVE_SYNC();
    }
    float* Ub = (float*)(p->ws + A_U) + (long)ctask * 4096 + lane * 64;
    bf16_t* Pb = (bf16_t*)(p->ws + B_PB) + (long)ctask * 4096 + lane * 64;
#pragma unroll
    for (int jj = 0; jj < 32; ++jj) { *(f32x2*)(Ub + 2 * jj) = U[jj]; *(uint32_t*)(Pb + 2 * jj) = pack2(Pm[jj].x, Pm[jj].y); }
}
__device__ __forceinline__ void chain_item(PP p, int jl, int sh, char* smem) {
    const int tid = TIDX, i = tid >> 3, jq = tid & 7;
    float* Sl = (float*)smem;
    float* Pl = (float*)(smem + 16640);
    f32x2 acc[4];
    __syncthreads();
#pragma unroll
    for (int jj = 0; jj < 8; ++jj) Sl[i * 65 + jq * 8 + jj] = 0.f;
    const bf16_t* Pb0 = (const bf16_t*)(p->ws + B_PB) + (long)sh * 128 * 4096 + tid * 8;
    float* Ub0 = (float*)(p->ws + A_U) + (long)sh * 128 * 4096 + i * 64 + jq * 8;
    u32x4 pn = *(const u32x4*)Pb0;
    f32x4 un0 = *(const f32x4*)Ub0, un1 = *(const f32x4*)(Ub0 + 4);
    for (int c = 0; c < 128; ++c) {
        const u32x4 pc = pn; const f32x4 uc0 = un0, uc1 = un1;
        __syncthreads();
        {
            float* d = Pl + tid * 8;
            *(f32x4*)d = (f32x4){bf2f(pc.x & 0xffff), bf2f(pc.x >> 16), bf2f(pc.y & 0xffff), bf2f(pc.y >> 16)};
            *(f32x4*)(d + 4) = (f32x4){bf2f(pc.z & 0xffff), bf2f(pc.z >> 16), bf2f(pc.w & 0xffff), bf2f(pc.w >> 16)};
        }
        if (c + 1 < 128) { pn = *(const u32x4*)(Pb0 + (long)(c + 1) * 4096); un0 = *(const f32x4*)(Ub0 + (long)(c + 1) * 4096); un1 = *(const f32x4*)(Ub0 + (long)(c + 1) * 4096 + 4); }
        acc[0] = uc0.xy; acc[1] = uc0.zw; acc[2] = uc1.xy; acc[3] = uc1.zw;
        __syncthreads();
#pragma unroll 8
        for (int j0 = 0; j0 < 64; ++j0) {
            const float sv = Sl[i * 65 + j0];
            const f32x2 sv2 = {sv, sv};
            const f32x4 v0 = *(const f32x4*)(Pl + j0 * 64 + jq * 8), v1 = *(const f32x4*)(Pl + j0 * 64 + jq * 8 + 4);
            acc[0] += v0.xy * sv2; acc[1] += v0.zw * sv2; acc[2] += v1.xy * sv2; acc[3] += v1.zw * sv2;
        }
        __syncthreads();
#pragma unroll
        for (int q = 0; q < 4; ++q) { Sl[i * 65 + jq * 8 + 2 * q] = acc[q].x; Sl[i * 65 + jq * 8 + 2 * q + 1] = acc[q].y; }
        float* Ub = Ub0 + (long)c * 4096;
        *(f32x4*)Ub = (f32x4){acc[0].x, acc[0].y, acc[1].x, acc[1].y};
        *(f32x4*)(Ub + 4) = (f32x4){acc[2].x, acc[2].y, acc[3].x, acc[3].y};
    }
    const int b = sh >> 3, hd = sh & 7;
    float* So = p->out + O_PRW + ((long)(jl * 2 + b) * 8 + hd) * 4096 + i * 64 + jq * 8;
    *(f32x4*)So = (f32x4){acc[0].x, acc[0].y, acc[1].x, acc[1].y};
    *(f32x4*)(So + 4) = (f32x4){acc[2].x, acc[2].y, acc[3].x, acc[3].y};
    __syncthreads();
}
__device__ __forceinline__ void fin_task(PP p, int jl, int task, float* wl) {
    const int lane = TIDX & 63;
    const bool isP = task < 2048;
    int hd, row0, nsteps, c = 0;
    if (isP) { const int sh = task >> 7; c = task & 127; const int b = sh >> 3; hd = sh & 7; row0 = b * 16384 + c * 128; nsteps = 128; }
    else { const int t2 = task - 2048; const int sb = t2 >> 3; hd = t2 & 7; row0 = MP + sb * 64; nsteps = 64; }
    const bool corr = isP && c > 0;
    f32x2 S[32];
    if (corr) {
        const float* Ub = (const float*)(p->ws + A_U) + (long)(task - 1) * 4096 + lane * 64;
#pragma unroll
        for (int jj = 0; jj < 32; ++jj) S[jj] = *(const f32x2*)(Ub + 2 * jj);
    } else {
#pragma unroll
        for (int jj = 0; jj < 32; ++jj) S[jj] = (f32x2){0.f, 0.f};
    }
    const int col = hd * 64 + lane;
    const float kaw = p->in[28][jl * 512 + col], rk = p->in[29][jl * 512 + col], lw = p->in[30][jl * 512 + col], lb = p->in[31][jl * 512 + col];
    const bf16_t* AA = (const bf16_t*)(p->ws + B_AA);
    const bf16_t* G = (const bf16_t*)(p->ws + B_G);
    const bf16_t* R = (const bf16_t*)(p->ws + A_R);
    const bf16_t* Kb = (const bf16_t*)(p->ws + A_K);
    const bf16_t* Vb = (const bf16_t*)(p->ws + A_V);
    bf16_t* MIX = (bf16_t*)(p->ws + WS_H);
    const bf16_t* QT = (const bf16_t*)(p->ws + A_QT);
    bf16_t ny[4], nr[4], nk[4], na[4], nv[4], ng[4], nq[4];
#define FIN_LOAD(T0) { _Pragma("unroll") for (int st = 0; st < 4; ++st) { const long row = row0 + (T0) + st; const long idx = row * 512 + col; \
        ny[st] = MIX[row * 1024 + 512 + col]; nr[st] = R[idx]; nk[st] = Kb[idx]; na[st] = AA[idx]; nv[st] = Vb[idx]; ng[st] = G[idx]; nq[st] = corr ? QT[idx] : (bf16_t)0; } }
    FIN_LOAD(0)
    for (int t0 = 0; t0 < nsteps; t0 += 4) {
        float yv[4], rv[4], kv[4], av[4], vv[4], gv[4];
#pragma unroll
        for (int st = 0; st < 4; ++st) {
            yv[st] = bf2f(ny[st]); rv[st] = bf2f(nr[st]); kv[st] = bf2f(nk[st]); av[st] = bf2f(na[st]); vv[st] = bf2f(nv[st]); gv[st] = bf2f(ng[st]);
            if (corr) wl[st * 64 + lane] = bf2f(nq[st]);
        }
        if (t0 + 4 < nsteps) FIN_LOAD(t0 + 4)
        WAVE_SYNC();
        if (corr) {
#pragma unroll
            for (int st = 0; st < 4; ++st) {
                const f32x4* q4 = (const f32x4*)(wl + st * 64);
                f32x2 c0 = {0.f, 0.f}, c1 = {0.f, 0.f};
#pragma unroll
                for (int h = 0; h < 2; ++h) {
                    f32x4 t[8];
#pragma unroll
                    for (int i = 0; i < 8; ++i) t[i] = q4[h * 8 + i];
#pragma unroll
                    for (int i = 0; i < 8; ++i) { c0 += S[h * 16 + 2 * i] * t[i].xy; c1 += S[h * 16 + 2 * i + 1] * t[i].zw; }
                }
                yv[st] += (c0.x + c0.y) + (c1.x + c1.y);
            }
        }
        float r0[4], r1[4], r2[4];
#pragma unroll
        for (int st = 0; st < 4; ++st) { r0[st] = yv[st]; r1[st] = yv[st] * yv[st]; r2[st] = rv[st] * (kv[st] * (1.f + (av[st] - 1.f) * kaw)) * rk; }
#pragma unroll
        for (int o = 32; o >= 1; o >>= 1) {
            float t0_[4], t1_[4], t2_[4];
#pragma unroll
            for (int st = 0; st < 4; ++st) { t0_[st] = __shfl_xor(r0[st], o); t1_[st] = __shfl_xor(r1[st], o); t2_[st] = __shfl_xor(r2[st], o); }
#pragma unroll
            for (int st = 0; st < 4; ++st) { r0[st] += t0_[st]; r1[st] += t1_[st]; r2[st] += t2_[st]; }
        }
#pragma unroll
        for (int st = 0; st < 4; ++st) {
            const long row = row0 + t0 + st;
            const float mu = r0[st] * (1.0f / 64.0f);
            const float var = fmaxf(r1[st] * (1.0f / 64.0f) - mu * mu, 0.f);
            const float yn = (yv[st] - mu) * rsqrtf(var + 64e-5f) * lw + lb;
            MIX[row * 1024 + 512 + col] = f2bf((yn + r2[st] * vv[st]) * gv[st]);
        }
        WAVE_SYNC();
    }
}


#define XB_TMO      128
#define XB_XCNT(j)  (256  + 64 * (j))
#define XB_XSUB(j)  (1280 + 64 * (j))
#define XB_XGEN(j)  (2304 + 64 * (j))
#define XB_TOP      3328
#define XB_TOPGEN   3392
#define XCD_BAR_WORDS 3456
#define XB_SPIN_CAP (1u << 28)
__device__ __forceinline__ unsigned xb_ld(unsigned* p)              { return __hip_atomic_load(p, __ATOMIC_RELAXED, __HIP_MEMORY_SCOPE_AGENT); }
__device__ __forceinline__ unsigned xb_add(unsigned* p, unsigned v) { return __hip_atomic_fetch_add(p, v, __ATOMIC_RELAXED, __HIP_MEMORY_SCOPE_AGENT); }
__device__ __forceinline__ unsigned xb_xcc_id() { return (unsigned)__builtin_amdgcn_s_getreg((3 << 11) | 20) & 0xFu; }
#define XB_SPIN(cond, bar) do { unsigned _sp = 0; while (cond) { __builtin_amdgcn_s_sleep(1); \
    if ((++_sp & 255u) == 0u) { if (xb_ld(&(bar)[XB_TMO])) break; if (_sp > XB_SPIN_CAP) { atomicAdd(&(bar)[XB_TMO], 1u); break; } } } } while (0)
struct XcdBarrier { unsigned* bar; unsigned x; volatile LAS unsigned* st; };
__device__ __forceinline__ XcdBarrier xcd_barrier_post(unsigned* bar, volatile LAS unsigned* st) {
    XcdBarrier b; b.bar = bar; b.x = xb_xcc_id(); b.st = st;
    if (threadIdx.x == 0) (void)xb_add(&bar[XB_XCNT(b.x)], 1u);
    return b;
}
__device__ __forceinline__ void xcd_barrier_complete(unsigned* bar, unsigned x, unsigned& nloc, unsigned& nx) {
    const unsigned G = gridDim.x * gridDim.y * gridDim.z;
    unsigned sum, cnt, mine, sp = 0u;
    for (;;) {
        sum = 0u; cnt = 0u; mine = 0u;
#pragma unroll
        for (unsigned j = 0; j < 16; ++j) { const unsigned c = xb_ld(&bar[XB_XCNT(j)]); sum += c; cnt += (c > 0u) ? 1u : 0u; mine = (j == x) ? c : mine; }
        if (sum == G) break;
        __builtin_amdgcn_s_sleep(1);
        if ((++sp & 255u) == 0u) { if (xb_ld(&bar[XB_TMO])) break; if (sp > XB_SPIN_CAP) { atomicAdd(&bar[XB_TMO], 1u); break; } }
    }
    nloc = mine > 0u ? mine : 1u; nx = cnt > 0u ? cnt : 1u;
}
__device__ __forceinline__ void xcd_barrier(const XcdBarrier& b) {
    asm volatile("s_waitcnt vmcnt(0)" ::: "memory");
    __syncthreads();
    if (threadIdx.x == 0) {
        unsigned* bar = b.bar;
        __builtin_amdgcn_s_waitcnt(0);
        unsigned nloc = b.st[0], nx = b.st[1];
        const unsigned old = xb_add(&bar[XB_XSUB(b.x)], 1u);
        const unsigned gen = old / nloc;
        if (old + 1u == (gen + 1u) * nloc) {
            __builtin_amdgcn_fence(__ATOMIC_RELEASE, "agent");
            asm volatile("s_waitcnt vmcnt(0)" ::: "memory");
            const unsigned og = xb_add(&bar[XB_TOP], 1u);
            const unsigned tg = og / nx;
            if (og + 1u == (tg + 1u) * nx) xb_add(&bar[XB_TOPGEN], 1u);
            else XB_SPIN(xb_ld(&bar[XB_TOPGEN]) == tg, bar);
            __builtin_amdgcn_fence(__ATOMIC_ACQUIRE, "agent");
            xb_add(&bar[XB_XGEN(b.x)], 1u);
            asm volatile("s_waitcnt vmcnt(0)" ::: "memory");
        } else {
            XB_SPIN(xb_ld(&bar[XB_XGEN(b.x)]) == gen, bar);
            __builtin_amdgcn_fence(__ATOMIC_ACQUIRE, "agent");
            asm volatile("s_waitcnt vmcnt(0)" ::: "memory");
        }
    }
    __syncthreads();
}

#define GSYNC() xcd_barrier(xb)
#ifndef DUP_FFNIN
#define DUP_FFNIN 0
#endif
#ifndef DUP_MLA
#define DUP_MLA 0
#endif
#ifndef DUP_SCAN
#define DUP_SCAN 0
#endif
#ifndef DUP_NORM
#define DUP_NORM 0
#endif
#ifndef DUP_MISC
#define DUP_MISC 0
#endif
#ifndef DUP_RESID
#define DUP_RESID 0
#endif
#ifndef DUP_ODD
#define DUP_ODD 0
#endif
#define LAUNDER(q) PP q = (PP)__builtin_amdgcn_kernarg_segment_ptr(); asm volatile("" : "+s"(q));

__global__ void __launch_bounds__(NTHR, 2) fwd_megakernel(Params p0) {
    cg::grid_group grid = cg::this_grid();
    __shared__ __attribute__((aligned(16))) char smem[SMEM_BYTES];
    __shared__ uint4 xb_words;
    const int G = gridDim.x, bid = blockIdx.x;
    if (threadIdx.x == 0) xb_words = make_uint4(0u, 0u, 0u, 0u);
    __syncthreads();
    XcdBarrier xb = xcd_barrier_post((unsigned*)p0.ws, (volatile LAS unsigned*)&xb_words);
    { LAUNDER(p) phase0(p, smem); }
    grid.sync();
    if (threadIdx.x == 0) { unsigned nloc, nx; xcd_barrier_complete(xb.bar, xb.x, nloc, nx); xb.st[0] = nloc; xb.st[1] = nx; }
    __syncthreads();
#pragma unroll 1
    for (int l = 0; l < 4; ++l) {
        const int jl = l >> 1;
        const bool odd = l & 1;
        {
            LAUNDER(p)
            const int wave = TIDX >> 6;
            conv_phase(p, l, bid, G, smem);
            norm_phase(p, l, 0, bid * 8 + wave, G * 8);
        }
        GSYNC();
#pragma unroll 1
        for (int f = 0; f < 2; ++f) {
            if (f == 1) {
                LAUNDER(p)
                const int wave = TIDX >> 6;
                norm_phase(p, l, 2, bid * 8 + wave, G * 8);
                GSYNC();
            }
            for (int rep = 0; rep <= DUP_FFNIN; ++rep) {
                LAUNDER(p)
                for (int T = bid; T < 132 * 22; T += G) { int pm, pn; tile_map256(T, 132, 22, pm, pn); t256_ffn_in(p, f, pm, pn, smem); }
                GSYNC();
            }
            for (int rep = 0; rep <= DUP_RESID; ++rep) {
                LAUNDER(p)
                for (int T = bid; T < 512 + 16 * 11; T += G) {
                    int pm, pn;
                    if (T < 512) {
                        tile_map256(T, 132, 4, pm, pn);
                        t256_resid(p, (const bf16_t*)(p->ws + WS_BIG), 2816, (const bf16_t*)(p->ws + W_FO) + (long)f * 1024 * 2816, 2816, l, f == 0 ? 2 : 8, rep ? 0.f : 0.5f, pm, pn, smem);
                    } else {
                        const int u = T - 512; tile_map256(512 + u / 11, 132, 4, pm, pn);
                        t256_resid(p, (const bf16_t*)(p->ws + WS_BIG), 2816, (const bf16_t*)(p->ws + W_FO) + (long)f * 1024 * 2816, 2816, l, f == 0 ? 2 : 8, rep ? 0.f : 0.5f, pm, pn, smem, (u % 11) * 256, 256, true);
                    }
                }
                GSYNC();
            }
            if (f == 1) break;
            for (int rep = 0; rep <= DUP_NORM; ++rep) {
                LAUNDER(p)
                const int wave = TIDX >> 6;
                norm_phase(p, l, 1, bid * 8 + wave, G * 8);
                GSYNC();
            }
            if (!odd) {
                for (int rep = 0; rep <= DUP_MISC; ++rep) {
                    LAUNDER(p)
                    for (int T = bid; T < 132 * 12; T += G) { int pm, pn; tile_map256(T, 132, 12, pm, pn); t256_even_in(p, pm, pn, smem); }
                    GSYNC();
                }
                for (int rep = 0; rep <= DUP_MISC; ++rep) {
                    LAUNDER(p)
                    const int tid = TIDX, wave = tid >> 6;
                    for (int row = bid * 8 + wave; row < MT; row += G * 8) even_prep_row(p, jl, row);
                    const long gtid = (long)bid * NTHR + tid, gsz = (long)G * NTHR;
                    const float* cc = p->in[2] + (long)jl * 16 * 4096 * 256;
                    bf16_t* CK = (bf16_t*)(p->ws + A_CKV);
                    for (long i0 = gtid; i0 < 16L * 4096 * 64; i0 += 4 * gsz) {
                        f32x4 v4[4];
#pragma unroll
                        for (int u = 0; u < 4; ++u) v4[u] = *(const f32x4*)(cc + (i0 + u * gsz) * 4);
#pragma unroll
                        for (int u = 0; u < 4; ++u) {
                            const long e = (i0 + u * gsz) * 4; const int sb = (int)(e >> 20); const long rem = e & ((1 << 20) - 1);
                            uint2 w; w.x = pack2(v4[u].x, v4[u].y); w.y = pack2(v4[u].z, v4[u].w);
                            *(uint2*)(CK + ((long)MP + (long)sb * 4160) * 256 + rem) = w;
                        }
                    }
                    const float* kc = p->in[3] + (long)jl * 16 * 4096 * 32;
                    bf16_t* KR = (bf16_t*)(p->ws + A_KR);
                    for (long i = gtid; i < 16L * 4096 * 8; i += gsz) {
                        const long e = i * 4; const int sb = (int)(e >> 17); const long rem = e & ((1 << 17) - 1);
                        const float4 v = *(const float4*)(kc + e);
                        uint2 w; w.x = pack2(v.x, v.y); w.y = pack2(v.z, v.w);
                        *(uint2*)(KR + ((long)MP + (long)sb * 4160) * 32 + rem) = w;
                    }
                    GSYNC();
                }
                for (int rep = 0; rep <= DUP_MISC; ++rep) {
                    LAUNDER(p)
                    const int nq = 132 * 3, nl = 3 * 264 * 4 / 2;
                    for (int T = bid; T < nq + nl; T += G) {
                        if (T < nq) { int pm, pn; tile_map256(T, 132, 3, pm, pn); t256_qup(p, pm, pn, smem); }
                        else {
                            const int half = TIDX >> 8;
                            const int t2 = (T - nq) * 2 + half; const int which = t2 / (264 * 4);
                            int mt, nt; tile_map(t2 % (264 * 4), 264, 4, mt, nt);
                            tile_lora(p, jl, which, mt, nt, smem + half * HALF_LDS);
                        }
                    }
                    GSYNC();
                }
                for (int rep = 0; rep <= DUP_SCAN; ++rep) {
                    LAUNDER(p)
                    const int wave = TIDX >> 6;
                    float* wl = (float*)smem + wave * 1536;
                    const int nscan = 16 + 256;
                    for (int T = bid; T < nscan + 388 * 4; T += G) {
                        if (T < 16) { __syncthreads(); scan_task(p, jl, 4096 + T * 8 + wave, wl); __syncthreads(); }
                        else if (T < nscan) { __syncthreads(); scan_fused(p, jl, (T - 16) * 8 + wave, wl); __syncthreads(); }
                        else { int pm, pn; tile_map256(T - nscan, 388, 4, pm, pn); t256_kvup(p, pm, pn, smem); }
                    }
                    GSYNC();
                }
                _Pragma("unroll 1") for (int rep = 0; rep <= DUP_MLA; ++rep) {
                    LAUNDER(p)
                    for (int i = 0; i * G < 16 + 128 + 1024; ++i) {
                        const int T = i * G + ((i & 1) ? G - 1 - bid : bid);
                        if (T >= 16 + 128 + 1024) continue;
                        if (T < 16) { if (rep == 0) chain_item(p, jl, T, smem); }
                        else mla_item(p, T - 16, smem);
                    }
                    GSYNC();
                }
                {
                    LAUNDER(p)
                    const int wave = TIDX >> 6;
                    float* wl = (float*)smem + wave * 1536;
                    for (int T = bid; T < (2048 + 128) / 8; T += G) { __syncthreads(); fin_task(p, jl, T * 8 + wave, wl); __syncthreads(); }
                }
                GSYNC();
                {
                    LAUNDER(p)
                    for (int T = bid; T < 512 + 16 * 4; T += G) {
                        int pm, pn;
                        if (T < 512) { tile_map256(T, 132, 4, pm, pn); t256_resid(p, (const bf16_t*)(p->ws + WS_H), 1024, (const bf16_t*)(p->ws + W_EO), 1024, l, 5, 1.0f, pm, pn, smem); }
                        else { const int u = T - 512; tile_map256(512 + (u >> 2), 132, 4, pm, pn); t256_resid(p, (const bf16_t*)(p->ws + WS_H), 1024, (const bf16_t*)(p->ws + W_EO), 1024, l, 5, 1.0f, pm, pn, smem, (u & 3) * 256, 256, true); }
                    }
                }
                GSYNC();
            } else {
                for (int rep = 0; rep <= DUP_ODD; ++rep) {
                    LAUNDER(p)
                    for (int T = bid; T < 132 * 6; T += G) { int pm, pn; tile_map256(T, 132, 6, pm, pn); t256_oddqkv(p, jl, pm, pn, smem); }
                    const long gtid = (long)bid * NTHR + TIDX, gsz = (long)G * NTHR;
                    bf16_t* SK = (bf16_t*)(p->ws + B_SWK);
                    bf16_t* SVT = (bf16_t*)(p->ws + B_SWVT);
                    for (long i = gtid; i < 16L * 128 * 256; i += gsz) {
                        const int c = (int)(i & 255); const int r = (int)((i >> 8) & 127); const int sb = (int)(i >> 15);
                        const long src = ((long)(jl * 16 + sb) * 128 + r) * 256 + c;
                        const long keyrow = (long)MP + sb * 192 + r;
                        SK[keyrow * 256 + c] = f2bf(p->in[6][src]);
                        SVT[(long)c * SROWS + keyrow] = f2bf(p->in[7][src]);
                    }
                    GSYNC();
                }
                for (int rep = 0; rep <= DUP_ODD; ++rep) {
                    LAUNDER(p)
                    for (int T = bid; T < 2048 + 64; T += G) swa_item(p, jl, T, smem);
                    GSYNC();
                }
                {
                    LAUNDER(p)
                    for (int T = bid; T < 512 + 16 * 4; T += G) {
                        int pm, pn;
                        if (T < 512) { tile_map256(T, 132, 4, pm, pn); t256_resid(p, (const bf16_t*)(p->ws + WS_H), 1024, (const bf16_t*)(p->ws + W_OO), 1024, l, 5, 1.0f, pm, pn, smem); }
                        else { const int u = T - 512; tile_map256(512 + (u >> 2), 132, 4, pm, pn); t256_resid(p, (const bf16_t*)(p->ws + WS_H), 1024, (const bf16_t*)(p->ws + W_OO), 1024, l, 5, 1.0f, pm, pn, smem, (u & 3) * 256, 256, true); }
                    }
                }
                GSYNC();
            }
        }
    }
    {
        LAUNDER(p)
        const int wave = TIDX >> 6;
        for (int row = bid * 8 + wave; row < MT; row += G * 8) final_norm_row(p, row);
    }
}

extern "C" void kernel_launch(void* const* d_in, const int* in_sizes, int n_in, void* d_out, int out_size, void* d_ws, size_t ws_size,
                              hipStream_t stream) {
    static int grid_blocks = 0;
    if (!grid_blocks) {
        int dev = 0, cus = 0, per_cu = 0;
        hipGetDevice(&dev);
        hipDeviceGetAttribute(&cus, hipDeviceAttributeMultiprocessorCount, dev);
        hipOccupancyMaxActiveBlocksPerMultiprocessor(&per_cu, fwd_megakernel, NTHR, 0);
        per_cu = 1;
        grid_blocks = cus * per_cu;
    }
    Params p{};
    for (int i = 0; i < 37; ++i) p.in[i] = (const float*)d_in[i];
    p.out = (float*)d_out;
    p.ws = (char*)d_ws;
    void* args[] = {&p};
    (void)hipMemsetAsync(d_ws, 0, XCD_BAR_WORDS * 4, stream);
    hipError_t e = hipLaunchCooperativeKernel((void*)fwd_megakernel, dim3(grid_blocks), dim3(NTHR), args, 0, stream);
    if (e != hipSuccess) fprintf(stderr, "cooperative launch failed: %s (grid %d)\n", hipGetErrorString(e), grid_blocks);
}
```

```cpp
#include <hip/hip_runtime.h>
#include <hip/hip_cooperative_groups.h>
#include <stdint.h>
#include <stdio.h>
namespace cg = cooperative_groups;

typedef unsigned short bf16_t;
typedef short bf16x8 __attribute__((ext_vector_type(8)));
typedef float f32x4 __attribute__((ext_vector_type(4)));
typedef float f32x2 __attribute__((ext_vector_type(2)));
typedef unsigned u32x4 __attribute__((ext_vector_type(4)));
#define LAS __attribute__((address_space(3)))

constexpr int MT = 33792, MP = 32768;
constexpr long KROWS = 99328;
constexpr long SROWS = 35840;
constexpr int NTHR = 512;
constexpr int HT_ = 256;
constexpr int SMEM_BYTES = 131072;
constexpr int HALF_LDS = 40960;

constexpr long O_Y = 0;
constexpr long O_PCKV = 34603008;
constexpr long O_PKR = O_PCKV + 16777216;
constexpr long O_PRW = O_PKR + 2097152;
constexpr long O_PSH = O_PRW + 131072;
constexpr long O_PSK = O_PSH + 7168;
constexpr long O_PSV = O_PSK + 131072;
constexpr long O_SCKV = O_PSV + 131072;
constexpr long O_SKR = O_SCKV + 524288;
constexpr long O_SRW = O_SKR + 65536;
constexpr long O_SSH = O_SRW + 1048576;
constexpr long O_SSK = O_SSH + 57344;
constexpr long O_SSV = O_SSK + 1048576;

constexpr size_t WS_MODS = 16384;
constexpr size_t WS_ROPE = WS_MODS + 4ull * 18 * 9216 * 4;
constexpr size_t WS_W = WS_ROPE + 16384ull * 32 * 4;
constexpr size_t W_FI = WS_W;
constexpr size_t W_FO = W_FI + 2ull * 5632 * 1024 * 2;
constexpr size_t W_EI = W_FO + 2ull * 1024 * 2816 * 2;
constexpr size_t W_EO = W_EI + 3072ull * 1024 * 2;
constexpr size_t W_UQ = W_EO + 1024ull * 1024 * 2;
constexpr size_t W_UKV = W_UQ + 768ull * 768 * 2;
constexpr size_t W_W2 = W_UKV + 1024ull * 256 * 2;
constexpr size_t W_A2 = W_W2 + 512ull * 64 * 2;
constexpr size_t W_G2 = W_A2 + 512ull * 64 * 2;
constexpr size_t W_OQ = W_G2 + 512ull * 128 * 2;
constexpr size_t W_OO = W_OQ + 1536ull * 1024 * 2;
constexpr size_t WS_H = W_OO + 1024ull * 1024 * 2;
constexpr size_t WS_BIG = WS_H + (size_t)MT * 1024 * 2;
constexpr size_t BIG_BYTES = (size_t)MT * 3072 * 2;
constexpr size_t B_Q = WS_BIG;
constexpr size_t B_E = B_Q + (size_t)MT * 768 * 2;
constexpr size_t B_AA = B_E + (size_t)MT * 512 * 2;
constexpr size_t B_G = B_AA + (size_t)MT * 512 * 2;
constexpr size_t B_PB = B_G + (size_t)MT * 512 * 2;
constexpr size_t B_SWK = WS_BIG + (size_t)MT * 1024 * 2;
constexpr size_t B_SWVT = B_SWK + (size_t)SROWS * 256 * 2;
constexpr size_t WS_A = WS_BIG + BIG_BYTES;
constexpr size_t A_CQN = WS_A;
constexpr size_t A_QT = WS_A;
constexpr size_t A_U = WS_A + (size_t)MP * 512 * 2;
constexpr size_t A_LORA = A_CQN + (size_t)MT * 768 * 2;
constexpr size_t A_CKV = A_LORA + (size_t)MT * 256 * 2;
constexpr size_t A_KR = A_CKV + (size_t)KROWS * 256 * 2;
constexpr size_t A_R = A_KR + (size_t)KROWS * 32 * 2;
constexpr size_t A_K = A_R + (size_t)MT * 512 * 2;
constexpr size_t A_V = A_K + (size_t)MT * 512 * 2;
constexpr size_t WS_C = A_V + (size_t)MT * 512 * 2;
constexpr size_t C_KN = WS_C;
constexpr size_t C_VT = C_KN + (size_t)KROWS * 512 * 2;
constexpr size_t WS_END = C_VT + (size_t)KROWS * 512 * 2;
static_assert(B_PB + 2048ull * 4096 * 2 <= WS_BIG + BIG_BYTES, "big overflow");
static_assert(B_SWVT + (size_t)SROWS * 256 * 2 <= WS_BIG + BIG_BYTES, "big overflow odd");
static_assert(A_U + 2048ull * 4096 * 4 <= A_CKV, "U overlaps live data");
static_assert(WS_END < 785ull * 1024 * 1024, "ws too big");

struct Params {
    const float* in[37];
    float* out;
    char* ws;
};
typedef const __attribute__((address_space(4))) Params* PP;

__device__ __forceinline__ int tid_opaque() { int t = threadIdx.x; asm volatile("" : "+v"(t)); return t; }
#define TIDX tid_opaque()
#define TH (tid_opaque() & 255)
typedef __bf16 bf16v2_t __attribute__((ext_vector_type(2)));
typedef __bf16 bf16v8_t __attribute__((ext_vector_type(8)));
typedef float f32x8 __attribute__((ext_vector_type(8)));
__device__ __forceinline__ uint32_t pack2(float lo, float hi) { const f32x2 v = {lo, hi}; return __builtin_bit_cast(uint32_t, __builtin_convertvector(v, bf16v2_t)); }
__device__ __forceinline__ bf16_t f2bf(float f) { return (bf16_t)(pack2(f, 0.f) & 0xffffu); }
__device__ __forceinline__ float bf2f(bf16_t h) { return __uint_as_float(((uint32_t)h) << 16); }
__device__ __forceinline__ void seqinfo(int row, int& s, int& t) {
    if (row < MP) { s = row >> 14; t = row & 16383; }
    else { int r = row - MP; s = 2 + (r >> 6); t = r & 63; }
}
__device__ __forceinline__ float wave_sum(float v) {
#pragma unroll
    for (int o = 32; o >= 1; o >>= 1) v += __shfl_xor(v, o);
    return v;
}
__device__ __forceinline__ float sigmoidf_(float x) { return __builtin_amdgcn_rcpf(1.0f + __builtin_amdgcn_exp2f(-1.4426950408889634f * x)); }
#define WAVE_SYNC() do { __builtin_amdgcn_wave_barrier(); asm volatile("s_waitcnt lgkmcnt(0)" ::: "memory"); __builtin_amdgcn_wave_barrier(); } while (0)

__device__ __forceinline__ int srccol(int map, int n) {
    switch (map) {
        case 1: { int nt = n >> 8, lr = n & 255; return nt * 128 + (lr & 127) + (lr >= 128 ? 2816 : 0); }
        case 2: return n < 2848 ? n : -1;
        case 3: { if (n < 512) { int h = n >> 6, e = n & 63; return h * 96 + e; } int m = n - 512; int h = m >> 5, i = m & 31; return h * 96 + 64 + i; }
        case 4: { if (n < 512) { int h = n >> 6, e = n & 63; return h * 128 + e; } int m = n - 512; int h = m >> 6, d = m & 63; return h * 128 + 64 + d; }
        default: return n;
    }
}
struct ConvD { const float* src; int K, ld; bf16_t* dst; int map, idx; };
__device__ __forceinline__ void conv_load(const ConvD& d, f32x4 (&v)[4]) {
    const int KT = d.K >> 6;
    const int kt = d.idx % KT, nt = d.idx / KT;
    const int k0 = kt * 64, n0 = nt * 64;
    const int tid = TH;
    const int tk = tid >> 4, tn4 = (tid & 15) * 4;
    const int sc = srccol(d.map, n0 + tn4);
#pragma unroll
    for (int kk = 0; kk < 4; ++kk) {
        v[kk] = (f32x4){0.f, 0.f, 0.f, 0.f};
        if (sc >= 0) v[kk] = *(const f32x4*)(d.src + (long)(k0 + tk + 16 * kk) * d.ld + sc);
    }
}
__device__ __forceinline__ void conv_store(const ConvD& d, const f32x4 (&v)[4], char* smem) {
    float* sm = (float*)smem;
    const int KT = d.K >> 6;
    const int kt = d.idx % KT, nt = d.idx / KT;
    const int k0 = kt * 64, n0 = nt * 64;
    const int tid = TH;
    __syncthreads();
    {
        const int tk = tid >> 4, tn4 = (tid & 15) * 4;
#pragma unroll
        for (int kk = 0; kk < 4; ++kk) {
            const int k = tk + 16 * kk;
            sm[k * 65 + tn4 + 0] = v[kk][0]; sm[k * 65 + tn4 + 1] = v[kk][1]; sm[k * 65 + tn4 + 2] = v[kk][2]; sm[k * 65 + tn4 + 3] = v[kk][3];
        }
    }
    __syncthreads();
    {
        const int n = tid >> 2, kc = tid & 3;
        uint32_t w[8];
#pragma unroll
        for (int i = 0; i < 8; ++i) w[i] = pack2(sm[(kc * 16 + 2 * i) * 65 + n], sm[(kc * 16 + 2 * i + 1) * 65 + n]);
        u32x4* dd = (u32x4*)(d.dst + (long)(n0 + n) * d.K + k0 + kc * 16);
        dd[0] = (u32x4){w[0], w[1], w[2], w[3]};
        dd[1] = (u32x4){w[4], w[5], w[6], w[7]};
    }
}
#define CONV_TRY(SRC, K_, LD_, DSTOFF, ND, MAP) { const int nt_ = ((K_) / 64) * ((ND) / 64); if (idx < nt_) { d.src = (SRC); d.K = (K_); d.ld = (LD_); d.dst = (bf16_t*)(p->ws + (DSTOFF)); d.map = (MAP); d.idx = idx; return d; } idx -= nt_; }
__device__ __forceinline__ int conv_count(int l) {
    const int ffn = 2 * 1408 + 2 * 704;
    return (l & 1) ? ffn + 384 + 256 : ffn + 768 + 256 + 144 + 64 + 8 + 8 + 16;
}
__device__ __forceinline__ ConvD conv_desc(PP p, int l, int idx) {
    ConvD d; d.src = nullptr; d.K = 64; d.ld = 0; d.dst = nullptr; d.map = 0; d.idx = 0;
    const int j = l >> 1;
    CONV_TRY(p->in[13] + (long)(l * 2 + 0) * 1024 * 5632, 1024, 5632, W_FI, 5632, 1)
    CONV_TRY(p->in[13] + (long)(l * 2 + 1) * 1024 * 5632, 1024, 5632, W_FI + 5632ull * 1024 * 2, 5632, 1)
    CONV_TRY(p->in[14] + (long)(l * 2 + 0) * 2816 * 1024, 2816, 1024, W_FO, 1024, 0)
    CONV_TRY(p->in[14] + (long)(l * 2 + 1) * 2816 * 1024, 2816, 1024, W_FO + 1024ull * 2816 * 2, 1024, 0)
    if (l & 1) {
        CONV_TRY(p->in[32] + (long)j * 1024 * 1536, 1024, 1536, W_OQ, 1536, 0)
        CONV_TRY(p->in[34] + (long)j * 1024 * 1024, 1024, 1024, W_OO, 1024, 0)
    } else {
        CONV_TRY(p->in[15] + (long)j * 1024 * 2848, 1024, 2848, W_EI, 3072, 2)
        CONV_TRY(p->in[16] + (long)j * 1024 * 1024, 1024, 1024, W_EO, 1024, 0)
        CONV_TRY(p->in[19] + (long)j * 768 * 768, 768, 768, W_UQ, 768, 3)
        CONV_TRY(p->in[20] + (long)j * 256 * 1024, 256, 1024, W_UKV, 1024, 4)
        CONV_TRY(p->in[23] + (long)j * 64 * 512, 64, 512, W_W2, 512, 0)
        CONV_TRY(p->in[25] + (long)j * 64 * 512, 64, 512, W_A2, 512, 0)
        CONV_TRY(p->in[26] + (long)j * 128 * 512, 128, 512, W_G2, 512, 0)
    }
    return d;
}
__device__ __forceinline__ void conv_phase(PP p, int l, int bid, int G, char* smem) {
    const int half = TIDX >> 8;
    const int nc = conv_count(l);
    int idx = bid * 2;
    if (idx >= nc) return;
    f32x4 nv[4];
    ConvD nd = conv_desc(p, l, idx + half);
    conv_load(nd, nv);
    for (;;) {
        const ConvD cd = nd;
        f32x4 cv[4];
#pragma unroll
        for (int i = 0; i < 4; ++i) cv[i] = nv[i];
        const int nidx = idx + G * 2;
        if (nidx < nc) { nd = conv_desc(p, l, nidx + half); conv_load(nd, nv); }
        conv_store(cd, cv, smem + half * HALF_LDS);
        if (nidx >= nc) break;
        idx = nidx;
    }
}

__device__ __forceinline__ int swz(int r, int c) { return r * 64 + ((c ^ ((-(r >> 2)) & 3)) << 4); }

__device__ __forceinline__ void gemm_core(const bf16_t* __restrict__ A, long lda, const bf16_t* __restrict__ Bt, long ldb, int K,
                                          char* smem, f32x4 (&acc)[4][4]) {
    const int tid = TH, lane = tid & 63, w = tid >> 6, wm = w >> 1, wn = w & 1, lr = lane & 15, lq = lane >> 4;
    char* sA = smem;
    char* sB = smem + 16384;
#pragma unroll
    for (int mi = 0; mi < 4; ++mi)
#pragma unroll
        for (int ni = 0; ni < 4; ++ni) acc[mi][ni] = (f32x4){0.f, 0.f, 0.f, 0.f};
    const int lrow = tid >> 3, c8 = tid & 7;
    const bf16_t* ga = A + (long)lrow * lda + c8 * 8;
    const bf16_t* gb = Bt + (long)lrow * ldb + c8 * 8;
    const int loff = (c8 >> 2) * 8192;
    u32x4 ra[4], rb[4];
#pragma unroll
    for (int i = 0; i < 4; ++i) { ra[i] = *(const u32x4*)(ga + (long)(32 * i) * lda); rb[i] = *(const u32x4*)(gb + (long)(32 * i) * ldb); }
    const int KT = K >> 6;
    for (int kt = 0; kt < KT; ++kt) {
        __syncthreads();
#pragma unroll
        for (int i = 0; i < 4; ++i) {
            const int r = lrow + 32 * i;
            *(u32x4*)(sA + loff + swz(r, c8 & 3)) = ra[i];
            *(u32x4*)(sB + loff + swz(r, c8 & 3)) = rb[i];
        }
        __syncthreads();
        if (kt + 1 < KT) {
            const int k0 = (kt + 1) * 64;
#pragma unroll
            for (int i = 0; i < 4; ++i) { ra[i] = *(const u32x4*)(ga + (long)(32 * i) * lda + k0); rb[i] = *(const u32x4*)(gb + (long)(32 * i) * ldb + k0); }
        }
#pragma unroll
        for (int sub = 0; sub < 2; ++sub) {
            bf16x8 af[4], bfr[4];
#pragma unroll
            for (int mi = 0; mi < 4; ++mi) af[mi] = *(const bf16x8*)(sA + sub * 8192 + swz(wm * 64 + mi * 16 + lr, lq));
#pragma unroll
            for (int ni = 0; ni < 4; ++ni) bfr[ni] = *(const bf16x8*)(sB + sub * 8192 + swz(wn * 64 + ni * 16 + lr, lq));
#pragma unroll
            for (int mi = 0; mi < 4; ++mi)
#pragma unroll
                for (int ni = 0; ni < 4; ++ni) acc[mi][ni] = __builtin_amdgcn_mfma_f32_16x16x32_bf16(af[mi], bfr[ni], acc[mi][ni], 0, 0, 0);
        }
    }
}
__device__ __forceinline__ void tile_map(int T, int MTl, int NTl, int& mt, int& nt) {
    const int per_group = 8 * NTl;
    const int g = T / per_group, r = T - g * per_group;
    const int rem = MTl - g * 8;
    const int gsz = rem < 8 ? rem : 8;
    mt = g * 8 + r % gsz; nt = r / gsz;
}
#define EPI_IDX const int tid_ = TH, lane_ = tid_ & 63, w_ = tid_ >> 6, wm_ = w_ >> 1, wn_ = w_ & 1, lr_ = lane_ & 15, lq_ = lane_ >> 4; \
    const int rbase_ = mt * 128 + wm_ * 64 + lq_ * 4, cbase_ = nt * 128 + wn_ * 64 + lr_;

constexpr float QS_MLA = 0.10206207261596577f * 1.4426950408889634f;
constexpr float QS_SWA = 0.125f * 1.4426950408889634f;
constexpr int G_HT = 128 * 64;
__device__ __forceinline__ int lds_byte(int r, int c) {
    int st = (r >> 4) * 2 + (c >> 5), rr = r & 15, cc = c & 31, ob = rr * 64 + cc * 2;
    return st * 1024 + (ob ^ (((ob >> 9) & 1) << 5));
}
__device__ __forceinline__ void stage_rc(int b, int& R, int& C) {
    int st = b / 1024, sb = b % 1024, swz = sb ^ (((sb >> 9) & 1) << 5);
    R = (st >> 1) * 16 + swz / 64; C = (st & 1) * 32 + (swz % 64) / 2;
}
#define G_AS1 __attribute__((address_space(1)))
__device__ __forceinline__ void gemm256(const bf16_t* __restrict__ A, long lda, const bf16_t* __restrict__ Bt, long ldb, int K,
                                        int brow, int bcol, char* smem, f32x4 (&acc)[2][2][4][2]) {
    bf16_t* shm = (bf16_t*)smem;
    const int tid = TIDX;
#define SA(b, h) (shm + ((b) * 2 + (h)) * G_HT)
#define SB(b, h) (shm + (4 + (b) * 2 + (h)) * G_HT)
#define STAGE(P, BASE, LD, br, kt) do { const long _g = (long)(br) * (LD) + (long)(kt) * 64; \
    _Pragma("unroll") for (int _i = 0; _i < 2; ++_i) { const int _b = tid * 16 + _i * 8192; int _r, _c; stage_rc(_b, _r, _c); \
      __builtin_amdgcn_global_load_lds((const G_AS1 unsigned*)((BASE) + _g + (long)_r * (LD) + _c), \
        (LAS unsigned*)((char*)(P) + _b), 16, 0, 0); } } while (0)
#define LDA(dst, b, h) _Pragma("unroll") for (int m = 0; m < 4; ++m) _Pragma("unroll") for (int k = 0; k < 2; ++k) \
    dst[m][k] = *reinterpret_cast<const bf16x8*>((char*)SA(b, h) + lds_byte(wr * 64 + m * 16 + fr, k * 32 + fq * 8))
#define LDB(dst, b, h) _Pragma("unroll") for (int n = 0; n < 2; ++n) _Pragma("unroll") for (int k = 0; k < 2; ++k) \
    dst[n][k] = *reinterpret_cast<const bf16x8*>((char*)SB(b, h) + lds_byte(wc * 32 + n * 16 + fr, k * 32 + fq * 8))
#define MMA(ai, bj, At_, Bt_) do { __builtin_amdgcn_s_setprio(1); \
    _Pragma("unroll") for (int m = 0; m < 4; ++m) _Pragma("unroll") for (int n = 0; n < 2; ++n) _Pragma("unroll") for (int k = 0; k < 2; ++k) \
      acc[ai][bj][m][n] = __builtin_amdgcn_mfma_f32_16x16x32_bf16(At_[m][k], Bt_[n][k], acc[ai][bj][m][n], 0, 0, 0); \
    __builtin_amdgcn_s_setprio(0); } while (0)
#define WAIT_V(n) asm volatile("s_waitcnt vmcnt(" #n ")" ::: "memory")
#define WAIT_L(n) asm volatile("s_waitcnt lgkmcnt(" #n ")" ::: "memory")
#define BAR __builtin_amdgcn_s_barrier()
#define SCHED __builtin_amdgcn_sched_barrier(0)
    const int wid = tid >> 6, lane = tid & 63, wr = wid >> 2, wc = wid & 3, fr = lane & 15, fq = lane >> 4;
#pragma unroll
    for (int ai = 0; ai < 2; ++ai)
#pragma unroll
        for (int bj = 0; bj < 2; ++bj)
#pragma unroll
            for (int m = 0; m < 4; ++m)
#pragma unroll
                for (int n = 0; n < 2; ++n) acc[ai][bj][m][n] = (f32x4){0.f, 0.f, 0.f, 0.f};
    bf16x8 At[4][2], B0[2][2], B1[2][2];
    const int nt = K / 64;
    __syncthreads();
    STAGE(SB(0, 0), Bt, ldb, bcol, 0); STAGE(SA(0, 0), A, lda, brow, 0);
    STAGE(SB(0, 1), Bt, ldb, bcol + 128, 0); STAGE(SA(0, 1), A, lda, brow + 128, 0);
    if (wr == 1) BAR;
    WAIT_V(4); BAR;
    STAGE(SB(1, 0), Bt, ldb, bcol, 1); STAGE(SA(1, 0), A, lda, brow, 1); STAGE(SB(1, 1), Bt, ldb, bcol + 128, 1);
    WAIT_V(6); BAR;
    for (int t = 0; t < nt - 2; t += 2) {
        LDB(B0, 0, 0); SCHED; LDA(At, 0, 0); STAGE(SA(1, 1), A, lda, brow + 128, t + 1);
        WAIT_L(8); BAR; WAIT_L(0); MMA(0, 0, At, B0); BAR; SCHED;
        LDB(B1, 0, 1); STAGE(SB(0, 0), Bt, ldb, bcol, t + 2);
        BAR; WAIT_L(0); MMA(0, 1, At, B1); BAR;
        LDA(At, 0, 1); STAGE(SA(0, 0), A, lda, brow, t + 2);
        BAR; WAIT_L(0); MMA(1, 0, At, B0); BAR; SCHED;
        STAGE(SB(0, 1), Bt, ldb, bcol + 128, t + 2);
        WAIT_V(6); BAR; MMA(1, 1, At, B1); BAR;
        LDB(B0, 1, 0); SCHED; LDA(At, 1, 0); STAGE(SA(0, 1), A, lda, brow + 128, t + 2);
        WAIT_L(8); BAR; WAIT_L(0); MMA(0, 0, At, B0); BAR; SCHED;
        LDB(B1, 1, 1); STAGE(SB(1, 0), Bt, ldb, bcol, t + 3);
        BAR; WAIT_L(0); MMA(0, 1, At, B1); BAR;
        LDA(At, 1, 1); STAGE(SA(1, 0), A, lda, brow, t + 3);
        BAR; WAIT_L(0); MMA(1, 0, At, B0); BAR; SCHED;
        STAGE(SB(1, 1), Bt, ldb, bcol + 128, t + 3);
        WAIT_V(6); BAR; MMA(1, 1, At, B1); BAR;
    }
    { LDB(B0, 0, 0); LDA(At, 0, 0); STAGE(SA(1, 1), A, lda, brow + 128, nt - 1);
      BAR; WAIT_L(0); MMA(0, 0, At, B0); BAR;
      LDB(B1, 0, 1); BAR; WAIT_L(0); MMA(0, 1, At, B1); BAR;
      LDA(At, 0, 1); WAIT_V(4); BAR; WAIT_L(0); MMA(1, 0, At, B0); MMA(1, 1, At, B1); BAR; }
    { LDB(B0, 1, 0); LDA(At, 1, 0); WAIT_V(2); BAR; WAIT_L(0); MMA(0, 0, At, B0); BAR;
      LDB(B1, 1, 1); WAIT_V(0); BAR; WAIT_L(0); MMA(0, 1, At, B1); BAR;
      LDA(At, 1, 1); BAR; WAIT_L(0); MMA(1, 0, At, B0); MMA(1, 1, At, B1); BAR; }
    if (wr == 0) BAR;
}
__device__ __forceinline__ void tile_map256(int wgid, int nM, int nN, int& pm, int& pn) {
    const int nwg = nM * nN;
    { const int q = nwg / 8, r = nwg % 8, xcd = wgid % 8, off = wgid / 8; wgid = (xcd < r ? xcd * (q + 1) : r * (q + 1) + (xcd - r) * q) + off; }
    constexpr int WGM = 4;
    const int nig = WGM * nN, gid = wgid / nig, fm = gid * WGM;
    const int rem = nM - fm, gsz = rem < WGM ? rem : WGM;
    pm = fm + ((wgid % nig) % gsz); pn = (wgid % nig) / gsz;
}
#define EPI256 const int tid_ = TIDX, lane_ = tid_ & 63, wid_ = tid_ >> 6, wr_ = wid_ >> 2, wc_ = wid_ & 3, fr_ = lane_ & 15, fq_ = lane_ >> 4; \
    const int rb_ = pm * 256 + wr_ * 64 + fq_ * 4, cb_ = pn * 256 + wc_ * 32 + fr_;
#define ACC256 f32x4 acc[2][2][4][2]

__device__ __forceinline__ void t256_ffn_in(PP p, int wsel, int pm, int pn, char* smem) {
    ACC256;
    gemm256((const bf16_t*)(p->ws + WS_H), 1024, (const bf16_t*)(p->ws + W_FI) + (long)wsel * 5632 * 1024, 1024, 1024, pm * 256, pn * 256, smem, acc);
    EPI256
    bf16_t* U = (bf16_t*)(p->ws + WS_BIG);
#pragma unroll
    for (int ai = 0; ai < 2; ++ai)
#pragma unroll
        for (int m = 0; m < 4; ++m)
#pragma unroll
            for (int j = 0; j < 4; ++j) {
                const long row = rb_ + ai * 128 + m * 16 + j;
#pragma unroll
                for (int n = 0; n < 2; ++n) {
                    const int hu = pn * 128 + wc_ * 32 + n * 16 + fr_;
                    const float g = acc[ai][0][m][n][j], up = acc[ai][1][m][n][j];
                    U[row * 2816 + hu] = f2bf(g * sigmoidf_(g) * up);
                }
            }
}
__device__ __forceinline__ void t256_resid(PP p, const bf16_t* A0, long lda, const bf16_t* Bt0, int K, int l, int gi, float coef, int pm, int pn, char* smem,
                                           int k0 = 0, int klen = 0, bool atomic = false) {
    ACC256;
    if (klen == 0) klen = K;
    gemm256(A0 + k0, lda, Bt0 + k0, K, klen, pm * 256, pn * 256, smem, acc);
    EPI256
    const float* mods = (const float*)(p->ws + WS_MODS);
#pragma unroll
    for (int ai = 0; ai < 2; ++ai) {
        float xv[4][4][4], gv[4][4];
#pragma unroll
        for (int m = 0; m < 4; ++m) {
            const int row0 = rb_ + ai * 128 + m * 16;
            int s_, t_; seqinfo(row0, s_, t_);
            const float* gate = mods + ((long)(l * 18 + s_) * 9 + gi) * 1024;
#pragma unroll
            for (int c = 0; c < 4; ++c) gv[m][c] = coef * gate[cb_ + (c >> 1) * 128 + (c & 1) * 16];
            if (!atomic) {
#pragma unroll
                for (int j = 0; j < 4; ++j)
#pragma unroll
                    for (int c = 0; c < 4; ++c) xv[m][j][c] = p->out[(long)(row0 + j) * 1024 + cb_ + (c >> 1) * 128 + (c & 1) * 16];
            }
        }
#pragma unroll
        for (int m = 0; m < 4; ++m) {
            const int row0 = rb_ + ai * 128 + m * 16;
#pragma unroll
            for (int j = 0; j < 4; ++j)
#pragma unroll
                for (int c = 0; c < 4; ++c) {
                    float* xp = p->out + (long)(row0 + j) * 1024 + cb_ + (c >> 1) * 128 + (c & 1) * 16;
                    const float dv = gv[m][c] * acc[ai][c >> 1][m][c & 1][j];
                    if (atomic) atomicAdd(xp, dv); else *xp = xv[m][j][c] + dv;
                }
        }
    }
}
__device__ __forceinline__ void t256_even_in(PP p, int pm, int pn, char* smem) {
    ACC256;
    gemm256((const bf16_t*)(p->ws + WS_H), 1024, (const bf16_t*)(p->ws + W_EI), 1024, 1024, pm * 256, pn * 256, smem, acc);
    EPI256
    bf16_t* PJ = (bf16_t*)(p->ws + WS_BIG);
#pragma unroll
    for (int ai = 0; ai < 2; ++ai)
#pragma unroll
        for (int bj = 0; bj < 2; ++bj)
#pragma unroll
            for (int m = 0; m < 4; ++m)
#pragma unroll
                for (int n = 0; n < 2; ++n)
#pragma unroll
                    for (int j = 0; j < 4; ++j) PJ[(long)(rb_ + ai * 128 + m * 16 + j) * 3072 + cb_ + bj * 128 + n * 16] = f2bf(acc[ai][bj][m][n][j]);
}
__device__ __forceinline__ void t256_qup(PP p, int pm, int pn, char* smem) {
    ACC256;
    gemm256((const bf16_t*)(p->ws + A_CQN), 768, (const bf16_t*)(p->ws + W_UQ), 768, 768, pm * 256, pn * 256, smem, acc);
    EPI256
    bf16_t* Q = (bf16_t*)(p->ws + B_Q);
    const float* rope = (const float*)(p->ws + WS_ROPE);
    if (pn < 2) {
#pragma unroll
        for (int ai = 0; ai < 2; ++ai)
#pragma unroll
            for (int bj = 0; bj < 2; ++bj)
#pragma unroll
                for (int m = 0; m < 4; ++m)
#pragma unroll
                    for (int n = 0; n < 2; ++n)
#pragma unroll
                        for (int j = 0; j < 4; ++j) Q[(long)(rb_ + ai * 128 + m * 16 + j) * 768 + cb_ + bj * 128 + n * 16] = f2bf(acc[ai][bj][m][n][j] * QS_MLA);
    } else {
        float csv[2][4][4], snv[2][4][4];
#pragma unroll
        for (int ai = 0; ai < 2; ++ai)
#pragma unroll
            for (int m = 0; m < 4; ++m)
#pragma unroll
                for (int j = 0; j < 4; ++j) {
                    const int row = rb_ + ai * 128 + m * 16 + j;
                    int s, t; seqinfo(row, s, t);
                    const int pos = (row < MP) ? t : 4096 + t;
                    csv[ai][m][j] = rope[pos * 32 + fr_]; snv[ai][m][j] = rope[pos * 32 + 16 + fr_];
                }
#pragma unroll
        for (int ai = 0; ai < 2; ++ai)
#pragma unroll
            for (int m = 0; m < 4; ++m)
#pragma unroll
                for (int j = 0; j < 4; ++j) {
                    const int row = rb_ + ai * 128 + m * 16 + j;
                    const float cs = csv[ai][m][j], sn = snv[ai][m][j];
#pragma unroll
                    for (int bj = 0; bj < 2; ++bj) {
                        const float x1 = acc[ai][bj][m][0][j], x2 = acc[ai][bj][m][1][j];
                        const long o = (long)row * 768 + cb_ + bj * 128;
                        Q[o] = f2bf((x1 * cs - x2 * sn) * QS_MLA);
                        Q[o + 16] = f2bf((x1 * sn + x2 * cs) * QS_MLA);
                    }
                }
    }
}
__device__ __forceinline__ void t256_kvup(PP p, int pm, int pn, char* smem) {
    ACC256;
    gemm256((const bf16_t*)(p->ws + A_CKV), 256, (const bf16_t*)(p->ws + W_UKV), 256, 256, pm * 256, pn * 256, smem, acc);
    EPI256
    if (pn < 2) {
        bf16_t* KN = (bf16_t*)(p->ws + C_KN);
#pragma unroll
        for (int ai = 0; ai < 2; ++ai)
#pragma unroll
            for (int bj = 0; bj < 2; ++bj)
#pragma unroll
                for (int m = 0; m < 4; ++m)
#pragma unroll
                    for (int n = 0; n < 2; ++n)
#pragma unroll
                        for (int j = 0; j < 4; ++j) KN[(long)(rb_ + ai * 128 + m * 16 + j) * 512 + cb_ + bj * 128 + n * 16] = f2bf(acc[ai][bj][m][n][j]);
    } else {
        bf16_t* VT = (bf16_t*)(p->ws + C_VT);
#pragma unroll
        for (int ai = 0; ai < 2; ++ai)
#pragma unroll
            for (int bj = 0; bj < 2; ++bj)
#pragma unroll
                for (int m = 0; m < 4; ++m)
#pragma unroll
                    for (int n = 0; n < 2; ++n) {
                        const int d = cb_ + bj * 128 + n * 16 - 512;
                        uint2 v; v.x = pack2(acc[ai][bj][m][n][0], acc[ai][bj][m][n][1]); v.y = pack2(acc[ai][bj][m][n][2], acc[ai][bj][m][n][3]);
                        *(uint2*)(VT + (long)d * KROWS + rb_ + ai * 128 + m * 16) = v;
                    }
    }
}
__device__ __forceinline__ void t256_oddqkv(PP p, int jl, int pm, int pn, char* smem) {
    ACC256;
    gemm256((const bf16_t*)(p->ws + WS_H), 1024, (const bf16_t*)(p->ws + W_OQ), 1024, 1024, pm * 256, pn * 256, smem, acc);
    EPI256
    const float* bias = p->in[33] + jl * 1536;
    float bvv[2][2];
#pragma unroll
    for (int bj = 0; bj < 2; ++bj)
#pragma unroll
        for (int n = 0; n < 2; ++n) bvv[bj][n] = bias[cb_ + bj * 128 + n * 16];
    if (pn < 4) {
        bf16_t* Q = (bf16_t*)(p->ws + B_Q);
#pragma unroll
        for (int ai = 0; ai < 2; ++ai)
#pragma unroll
            for (int bj = 0; bj < 2; ++bj)
#pragma unroll
                for (int m = 0; m < 4; ++m)
#pragma unroll
                    for (int n = 0; n < 2; ++n)
#pragma unroll
                        for (int j = 0; j < 4; ++j) { const int col = cb_ + bj * 128 + n * 16; Q[(long)(rb_ + ai * 128 + m * 16 + j) * 1024 + col] = f2bf((acc[ai][bj][m][n][j] + bvv[bj][n]) * QS_SWA); }
    } else {
        const bool isK = pn == 4;
        bf16_t* SK = (bf16_t*)(p->ws + B_SWK);
        bf16_t* SVT = (bf16_t*)(p->ws + B_SWVT);
#pragma unroll
        for (int ai = 0; ai < 2; ++ai)
#pragma unroll
            for (int bj = 0; bj < 2; ++bj)
#pragma unroll
                for (int m = 0; m < 4; ++m)
#pragma unroll
                    for (int n = 0; n < 2; ++n) {
                        const int col = cb_ + bj * 128 + n * 16;
                        const int c = col - (isK ? 1024 : 1280);
                        const float bv = bvv[bj][n];
                        float v[4];
#pragma unroll
                        for (int j = 0; j < 4; ++j) v[j] = acc[ai][bj][m][n][j] + bv;
                        const int row0 = rb_ + ai * 128 + m * 16;
                        int s, t; seqinfo(row0, s, t);
                        const long keyrow0 = (row0 < MP) ? row0 : (MP + (long)(s - 2) * 192 + 128 + t);
                        if (isK) {
#pragma unroll
                            for (int j = 0; j < 4; ++j) SK[(keyrow0 + j) * 256 + c] = f2bf(v[j]);
                        } else {
                            uint2 pk; pk.x = pack2(v[0], v[1]); pk.y = pack2(v[2], v[3]);
                            *(uint2*)(SVT + (long)c * SROWS + keyrow0) = pk;
                        }
                        if (row0 < MP) {
                            if (t >= 16384 - 128) {
                                float* o = p->out + (isK ? O_PSK : O_PSV) + ((long)(jl * 2 + s) * 128 + (t - (16384 - 128))) * 256 + c;
#pragma unroll
                                for (int j = 0; j < 4; ++j) o[j * 256] = v[j];
                            }
                        } else {
                            float* o = p->out + (isK ? O_SSK : O_SSV) + ((long)(jl * 16 + (s - 2)) * 128 + 64 + t) * 256 + c;
#pragma unroll
                            for (int j = 0; j < 4; ++j) o[j * 256] = v[j];
                        }
                    }
    }
}
__device__ __forceinline__ void tile_lora(PP p, int jl, int which, int mt, int nt, char* smem) {
    f32x4 acc[4][4];
    const bf16_t* A = (const bf16_t*)(p->ws + A_LORA) + (long)mt * 128 * 256 + (which == 0 ? 0 : which == 1 ? 64 : 128);
    const int K = which == 2 ? 128 : 64;
    const bf16_t* Bt = (const bf16_t*)(p->ws + (which == 0 ? W_W2 : which == 1 ? W_A2 : W_G2)) + (long)nt * 128 * K;
    gemm_core(A, 256, Bt, K, K, smem, acc);
    EPI_IDX
    bf16_t* O = (bf16_t*)(p->ws + (which == 0 ? B_E : which == 1 ? B_AA : B_G));
    const float* bias = which == 0 ? p->in[22] + jl * 512 : p->in[24] + jl * 512;
    float bl[4];
#pragma unroll
    for (int ni = 0; ni < 4; ++ni) bl[ni] = bias[cbase_ + ni * 16];
#pragma unroll
    for (int mi = 0; mi < 4; ++mi)
#pragma unroll
        for (int ni = 0; ni < 4; ++ni)
#pragma unroll
            for (int j = 0; j < 4; ++j) {
                const int row = rbase_ + mi * 16 + j, col = cbase_ + ni * 16;
                float v = acc[mi][ni][j];
                if (which == 0) {
                    const float z = -(bl[ni] + v);
                    const float sp = z > 15.f ? z : __logf(1.f + __expf(z));
                    v = __expf(-sp - 0.5f);
                } else if (which == 1) {
                    v = sigmoidf_(bl[ni] + v);
                }
                O[(long)row * 512 + col] = f2bf(v);
            }
}
__device__ __forceinline__ void norm_phase(PP p, int l, int nsel, int first, int stride) {
    const int lane = TIDX & 63;
    const float* g = p->in[12] + (l * 3 + nsel) * 1024;
    int rg = first;
    if (rg >= MT / 4) return;
    f32x4 nx[4][4];
#define NORM_LOAD(RG) { const float* x_ = p->out + (long)(RG) * 4096; _Pragma("unroll") for (int r = 0; r < 4; ++r) _Pragma("unroll") for (int i = 0; i < 4; ++i) nx[r][i] = *(const f32x4*)(x_ + r * 1024 + i * 256 + lane * 4); }
    NORM_LOAD(rg)
    for (;;) {
        const int row = rg * 4;
        int s, t; seqinfo(row, s, t);
        const float* md = (const float*)(p->ws + WS_MODS) + (long)(l * 18 + s) * 9216;
        const float* sh = md + (nsel * 3) * 1024;
        const float* sc = md + (nsel * 3 + 1) * 1024;
        f32x4 v[4][4], ggv[4], s1v[4], s0v[4];
#pragma unroll
        for (int i = 0; i < 4; ++i) { const int c = i * 256 + lane * 4; ggv[i] = *(const f32x4*)(g + c); s1v[i] = *(const f32x4*)(sc + c); s0v[i] = *(const f32x4*)(sh + c); }
#pragma unroll
        for (int r = 0; r < 4; ++r)
#pragma unroll
            for (int i = 0; i < 4; ++i) v[r][i] = nx[r][i];
        const int rgn = rg + stride;
        if (rgn < MT / 4) NORM_LOAD(rgn)
        float ss[4];
#pragma unroll
        for (int r = 0; r < 4; ++r) {
            ss[r] = 0.f;
#pragma unroll
            for (int i = 0; i < 4; ++i) ss[r] += v[r][i][0] * v[r][i][0] + v[r][i][1] * v[r][i][1] + v[r][i][2] * v[r][i][2] + v[r][i][3] * v[r][i][3];
        }
#pragma unroll
        for (int o = 32; o >= 1; o >>= 1) {
            float t_[4];
#pragma unroll
            for (int r = 0; r < 4; ++r) t_[r] = __shfl_xor(ss[r], o);
#pragma unroll
            for (int r = 0; r < 4; ++r) ss[r] += t_[r];
        }
        bf16_t* h = (bf16_t*)(p->ws + WS_H) + (long)row * 1024;
#pragma unroll
        for (int i = 0; i < 4; ++i) {
            const f32x4 ga = ggv[i] * (s1v[i] + 1.f);
#pragma unroll
            for (int r = 0; r < 4; ++r) {
                const float rstd = rsqrtf(ss[r] * (1.0f / 1024.0f) + 1e-6f);
                const f32x4 o4 = v[r][i] * rstd * ga + s0v[i];
                uint2 o; o.x = pack2(o4[0], o4[1]); o.y = pack2(o4[2], o4[3]);
                *(uint2*)(h + r * 1024 + i * 256 + lane * 4) = o;
            }
        }
        if (rgn >= MT / 4) break;
        rg = rgn;
    }
}
__device__ __forceinline__ void final_norm_row(PP p, int row) {
    const int lane = TIDX & 63;
    float* x = p->out + (long)row * 1024;
    const float* g = p->in[36];
    float4 v[4];
    float ss = 0.f;
#pragma unroll
    for (int i = 0; i < 4; ++i) { v[i] = *(const float4*)(x + i * 256 + lane * 4); ss += v[i].x * v[i].x + v[i].y * v[i].y + v[i].z * v[i].z + v[i].w * v[i].w; }
    ss = wave_sum(ss);
    const float rstd = rsqrtf(ss * (1.0f / 1024.0f) + 1e-6f);
#pragma unroll
    for (int i = 0; i < 4; ++i) {
        const int c = i * 256 + lane * 4;
        const float4 gg = *(const float4*)(g + c);
        float4 o = make_float4(v[i].x * rstd * gg.x, v[i].y * rstd * gg.y, v[i].z * rstd * gg.z, v[i].w * rstd * gg.w);
        *(float4*)(x + c) = o;
    }
}

__device__ __forceinline__ void phase0(PP p, char* smem) {
    const int tid = TIDX;
    const long gtid = (long)blockIdx.x * NTHR + tid, gsz = (long)gridDim.x * NTHR;
    {
        const float4* xp = (const float4*)p->in[0]; const float4* xs = (const float4*)p->in[1];
        float4* o = (float4*)p->out;
        const long np = (long)MP * 256, ns = 1024L * 256;
        for (long i0 = gtid; i0 < np + ns; i0 += 4 * gsz) {
            f32x4 t4[4];
#pragma unroll
            for (int u = 0; u < 4; ++u) { const long i = i0 + u * gsz; t4[u] = (f32x4){0.f, 0.f, 0.f, 0.f}; if (i < np + ns) t4[u] = (i < np) ? *(const f32x4*)(xp + i) : *(const f32x4*)(xs + (i - np)); }
#pragma unroll
            for (int u = 0; u < 4; ++u) { const long i = i0 + u * gsz; if (i < np + ns) *(f32x4*)(o + i) = t4[u]; }
        }
    }
    for (long i = gtid; i < 16384L * 16; i += gsz) {
        const int pos = (int)(i >> 4), k = (int)(i & 15);
        const double f = exp(-(double)k / 16.0 * 9.210340371976184);
        const double ang = (double)pos * f;
        float* r = (float*)(p->ws + WS_ROPE);
        r[pos * 32 + k] = (float)cos(ang);
        r[pos * 32 + 16 + k] = (float)sin(ang);
    }
    for (long i = gtid; i < 2L * 2 * 16 * 64 * 256; i += gsz) {
        long r = i;
        const int c = (int)(r & 255); r >>= 8;
        const int row = (int)(r & 63); r >>= 6;
        const int sb = (int)(r & 15); r >>= 4;
        const int jl = (int)(r & 1); r >>= 1;
        const int kv = (int)r;
        const float* src = (kv ? p->in[7] : p->in[6]) + ((long)(jl * 16 + sb) * 128 + 64 + row) * 256 + c;
        p->out[(kv ? O_SSV : O_SSK) + ((long)(jl * 16 + sb) * 128 + row) * 256 + c] = *src;
    }
    {
        const int half = tid >> 8, th = tid & 255, kq = th >> 6, cl = th & 63;
        float* csm = (float*)(smem + half * HALF_LDS);
        for (int it = blockIdx.x * 2; it < 4 * 144; it += gridDim.x * 2) {
            const int item = it + half;
            const int l = item / 144, cc = item % 144;
            const int jcol = cc * 64 + cl;
            float acc[18];
#pragma unroll
            for (int s = 0; s < 18; ++s) acc[s] = 0.f;
            const float* w = p->in[10] + (long)l * 1024 * 9216 + jcol;
            for (int kc = 0; kc < 4; ++kc) {
                const int kb = kq * 256 + kc * 64;
                __syncthreads();
#pragma unroll
                for (int s = 0; s < 18; ++s) {
                    const float c = (s < 2) ? p->in[8][s * 1024 + kb + cl] : p->in[9][(s - 2) * 1024 + kb + cl];
                    csm[(kq * 18 + s) * 64 + cl] = c / (1.f + __expf(-c));
                }
                __syncthreads();
                for (int k0 = 0; k0 < 64; k0 += 16) {
                    float wv[16];
#pragma unroll
                    for (int u = 0; u < 16; ++u) wv[u] = w[(long)(kb + k0 + u) * 9216];
#pragma unroll
                    for (int u = 0; u < 16; ++u) {
#pragma unroll
                        for (int s = 0; s < 18; ++s) acc[s] += csm[(kq * 18 + s) * 64 + k0 + u] * wv[u];
                    }
                }
            }
            __syncthreads();
#pragma unroll
            for (int s = 0; s < 18; ++s) csm[(kq * 18 + s) * 64 + cl] = acc[s];
            __syncthreads();
            if (kq == 0) {
                const float b = p->in[11][l * 9216 + jcol];
                float* mods = (float*)(p->ws + WS_MODS);
#pragma unroll
                for (int s = 0; s < 18; ++s)
                    mods[(long)(l * 18 + s) * 9216 + jcol] = ((csm[s * 64 + cl] + csm[(18 + s) * 64 + cl]) + (csm[(36 + s) * 64 + cl] + csm[(54 + s) * 64 + cl])) + b;
            }
        }
    }
}

__device__ __forceinline__ void unpack4(uint2 u, float (&v)[4]) { v[0] = bf2f(u.x & 0xffff); v[1] = bf2f(u.x >> 16); v[2] = bf2f(u.y & 0xffff); v[3] = bf2f(u.y >> 16); }
__device__ __forceinline__ void even_prep_row(PP p, int jl, int row) {
    const int lane = TIDX & 63;
    int s, t; seqinfo(row, s, t);
    const bool isP = row < MP;
    const int pos = isP ? t : 4096 + t;
    const long keyrow = isP ? row : (MP + (long)(s - 2) * 4160 + 4096 + t);
    const bf16_t* pr = (const bf16_t*)(p->ws + WS_BIG) + (long)row * 3072;
    uint2 cqu[3], ckvu, cu[7], pu[7];
    float4 gq[3], gkv, muv[7], sh4[7];
    const float* gqp = p->in[17] + jl * 768;
    const float* mu = p->in[21] + jl * 1792;
    const bf16_t* prw = pr + 1056;
    const bf16_t* pv = pr - 3072 + 1056;
    const float* sh0 = p->in[5] + (long)(jl * 16 + (s - 2)) * 1792;
#pragma unroll
    for (int i = 0; i < 3; ++i) { cqu[i] = *(const uint2*)(pr + i * 256 + lane * 4); gq[i] = *(const float4*)(gqp + i * 256 + lane * 4); }
    ckvu = *(const uint2*)(pr + 768 + lane * 4);
    gkv = *(const float4*)(p->in[18] + jl * 256 + lane * 4);
    const float* rope = (const float*)(p->ws + WS_ROPE);
    float cs = 0.f, sn = 0.f, x1 = 0.f, x2 = 0.f;
    if (lane < 16) { cs = rope[pos * 32 + lane]; sn = rope[pos * 32 + 16 + lane]; x1 = bf2f(pr[1024 + lane]); x2 = bf2f(pr[1024 + 16 + lane]); }
#pragma unroll
    for (int i = 0; i < 7; ++i) {
        const int c = i * 256 + lane * 4;
        cu[i] = *(const uint2*)(prw + c);
        muv[i] = *(const float4*)(mu + c);
        pu[i] = make_uint2(0u, 0u); sh4[i] = make_float4(0.f, 0.f, 0.f, 0.f);
        if (t > 0) pu[i] = *(const uint2*)(pv + c);
        else if (!isP) sh4[i] = *(const float4*)(sh0 + c);
    }
    {
        float v[3][4]; float ss = 0.f;
#pragma unroll
        for (int i = 0; i < 3; ++i) { unpack4(cqu[i], v[i]); ss += v[i][0] * v[i][0] + v[i][1] * v[i][1] + v[i][2] * v[i][2] + v[i][3] * v[i][3]; }
        float v2[4]; unpack4(ckvu, v2);
        float ss2 = v2[0] * v2[0] + v2[1] * v2[1] + v2[2] * v2[2] + v2[3] * v2[3];
#pragma unroll
        for (int o = 32; o >= 1; o >>= 1) { const float a0 = __shfl_xor(ss, o), a1 = __shfl_xor(ss2, o); ss += a0; ss2 += a1; }
        const float rstd = rsqrtf(ss * (1.0f / 768.0f) + 1e-6f);
        bf16_t* o = (bf16_t*)(p->ws + A_CQN) + (long)row * 768;
#pragma unroll
        for (int i = 0; i < 3; ++i) {
            uint2 w;
            w.x = pack2(v[i][0] * rstd * gq[i].x, v[i][1] * rstd * gq[i].y);
            w.y = pack2(v[i][2] * rstd * gq[i].z, v[i][3] * rstd * gq[i].w);
            *(uint2*)(o + i * 256 + lane * 4) = w;
        }
        const float rstd2 = rsqrtf(ss2 * (1.0f / 256.0f) + 1e-6f);
        const int c = lane * 4;
        float4 ov = make_float4(v2[0] * rstd2 * gkv.x, v2[1] * rstd2 * gkv.y, v2[2] * rstd2 * gkv.z, v2[3] * rstd2 * gkv.w);
        float* op = isP ? p->out + O_PCKV + ((long)(jl * 2 + s) * 16384 + t) * 256 + c
                        : p->out + O_SCKV + ((long)(jl * 16 + (s - 2)) * 64 + t) * 256 + c;
        *(float4*)op = ov;
        uint2 w; w.x = pack2(ov.x, ov.y); w.y = pack2(ov.z, ov.w);
        *(uint2*)((bf16_t*)(p->ws + A_CKV) + keyrow * 256 + c) = w;
    }
    if (lane < 16) {
        const float o1 = x1 * cs - x2 * sn, o2 = x1 * sn + x2 * cs;
        float* op = isP ? p->out + O_PKR + ((long)(jl * 2 + s) * 16384 + t) * 32
                        : p->out + O_SKR + ((long)(jl * 16 + (s - 2)) * 64 + t) * 32;
        op[lane] = o1; op[16 + lane] = o2;
        bf16_t* kr = (bf16_t*)(p->ws + A_KR) + keyrow * 32;
        kr[lane] = f2bf(o1); kr[16 + lane] = f2bf(o2);
    }
    {
        const int tlast = isP ? 16383 : 63;
        float* sho = isP ? p->out + O_PSH + (long)(jl * 2 + s) * 1792 : p->out + O_SSH + (long)(jl * 16 + (s - 2)) * 1792;
        bf16_t* R = (bf16_t*)(p->ws + A_R) + (long)row * 512;
        bf16_t* Kb = (bf16_t*)(p->ws + A_K) + (long)row * 512;
        bf16_t* Vb = (bf16_t*)(p->ws + A_V) + (long)row * 512;
        bf16_t* L = (bf16_t*)(p->ws + A_LORA) + (long)row * 256;
#pragma unroll
        for (int i = 0; i < 7; ++i) {
            const int c = i * 256 + lane * 4;
            float cur[4], prev[4];
            unpack4(cu[i], cur);
            if (t > 0) unpack4(pu[i], prev);
            else { prev[0] = sh4[i].x; prev[1] = sh4[i].y; prev[2] = sh4[i].z; prev[3] = sh4[i].w; }
            float pm[4];
            pm[0] = cur[0] + (prev[0] - cur[0]) * muv[i].x; pm[1] = cur[1] + (prev[1] - cur[1]) * muv[i].y;
            pm[2] = cur[2] + (prev[2] - cur[2]) * muv[i].z; pm[3] = cur[3] + (prev[3] - cur[3]) * muv[i].w;
            if (t == tlast) *(float4*)(sho + c) = make_float4(cur[0], cur[1], cur[2], cur[3]);
            bf16_t* dst;
            if (c < 512) dst = R + c;
            else if (c < 576) { dst = L + (c - 512); pm[0] = tanhf(pm[0]); pm[1] = tanhf(pm[1]); pm[2] = tanhf(pm[2]); pm[3] = tanhf(pm[3]); }
            else if (c < 1088) dst = Kb + (c - 576);
            else if (c < 1600) dst = Vb + (c - 1088);
            else if (c < 1664) dst = L + 64 + (c - 1600);
            else { dst = L + 128 + (c - 1664); pm[0] = sigmoidf_(pm[0]); pm[1] = sigmoidf_(pm[1]); pm[2] = sigmoidf_(pm[2]); pm[3] = sigmoidf_(pm[3]); }
            uint2 w; w.x = pack2(pm[0], pm[1]); w.y = pack2(pm[2], pm[3]);
            *(uint2*)dst = w;
        }
    }
}

struct AttnW { const bf16_t* q1; const bf16_t* q2; bf16_t* o; long qg, og; int n64b, n64s, ngrp; const float* sinkp; int hq0; int dist0; };
struct AttnKV { const bf16_t* k1; long ldk1; const bf16_t* k2; long ldk2; const bf16_t* vt; long ldvt; int nkt; long ldq; long ldo; int has_sink; };
__device__ __forceinline__ float max3f(float a, float b, float c) { float r; asm("v_max3_f32 %0, %1, %2, %3" : "=v"(r) : "v"(a), "v"(b), "v"(c)); return r; }
template <int DQK>
__device__ __forceinline__ void attn_block(const AttnKV& a, const AttnW& gw, char* smem) {
    const int tid = TIDX, wv = tid >> 6, g = wv >> 1, wh = wv & 1, lane = tid & 63, lr = lane & 15, lq = lane >> 4;
    constexpr int KS = DQK / 32, KROWB = DQK * 2 + 32  , CPR = DQK / 8, VROWB = 272;
    constexpr int KBYTES = 128 * KROWB, VBYTES = 64 * VROWB, BUFB = KBYTES + VBYTES;
    static_assert(2 * BUFB <= SMEM_BYTES, "attention LDS");
    const int n64 = g < gw.ngrp ? gw.n64b + g * gw.n64s : 0;
    const float slope2 = a.has_sink ? exp2f(-0.5f * (float)(gw.hq0 + g + 1)) * 1.4426950408889634f : 0.f;
    const float sink2 = a.has_sink ? gw.sinkp[g] * 1.4426950408889634f : 0.f;
    const int dist0 = gw.dist0;
    const bool active = n64 > 0;
    bf16x8 qf[2][KS];
#pragma unroll
    for (int qt = 0; qt < 2; ++qt)
#pragma unroll
        for (int ks = 0; ks < KS; ++ks) qf[qt][ks] = (bf16x8){0, 0, 0, 0, 0, 0, 0, 0};
    if (active) {
#pragma unroll
        for (int qt = 0; qt < 2; ++qt) {
            const long r = wh * 32 + qt * 16 + lr;
            const bf16_t* qp = gw.q1 + g * gw.qg + r * a.ldq;
            qf[qt][0] = *(const bf16x8*)(qp + lq * 8);
            qf[qt][1] = *(const bf16x8*)(qp + 32 + lq * 8);
            if (KS == 3) qf[qt][KS - 1] = *(const bf16x8*)(gw.q2 + g * gw.qg + r * a.ldq + lq * 8);
        }
    }
    f32x4 ot[2][4];
    float m[2], l[2];
#pragma unroll
    for (int qt = 0; qt < 2; ++qt) {
#pragma unroll
        for (int i = 0; i < 4; ++i) ot[qt][i] = (f32x4){0.f, 0.f, 0.f, 0.f};
        m[qt] = a.has_sink ? sink2 : -1e30f; l[qt] = a.has_sink ? 1.f : 0.f;
    }
    constexpr int NKC = 128 * CPR / 512;
    u32x4 kregA[NKC], vregA[2];
    const bf16_t* kptr[NKC]; int kstr[NKC]; int klds[NKC];
    const bf16_t* vptr[2]; int vlds[2];
#pragma unroll
    for (int i_ = 0; i_ < NKC; ++i_) {
        const int id = tid + i_ * 512; const int r = id / CPR, c = id % CPR;
        if (c < 8) { kptr[i_] = a.k1 + (long)r * a.ldk1 + c * 8; kstr[i_] = 128 * (int)a.ldk1; }
        else { kptr[i_] = a.k2 + (long)r * a.ldk2 + (c - 8) * 8; kstr[i_] = 128 * (int)a.ldk2; }
        klds[i_] = r * KROWB + c * 16;
    }
#pragma unroll
    for (int i_ = 0; i_ < 2; ++i_) { const int id = tid + i_ * 512; const int d = id >> 4, c = id & 15; vptr[i_] = a.vt + (long)d * a.ldvt + c * 8; vlds[i_] = KBYTES + d * VROWB + c * 16; }
#define ATTN_PF(KT, KR_, VR_) do { \
        _Pragma("unroll") for (int i_ = 0; i_ < NKC; ++i_) { KR_[i_] = *(const u32x4*)kptr[i_]; kptr[i_] += kstr[i_]; } \
        _Pragma("unroll") for (int i_ = 0; i_ < 2; ++i_) { VR_[i_] = *(const u32x4*)vptr[i_]; vptr[i_] += 128; } } while (0)
#define ATTN_ST(BUF, KR_, VR_) do { char* kb_ = smem + (BUF) * BUFB; \
        _Pragma("unroll") for (int i_ = 0; i_ < NKC; ++i_) *(u32x4*)(kb_ + klds[i_]) = KR_[i_]; \
        _Pragma("unroll") for (int i_ = 0; i_ < 2; ++i_) *(u32x4*)(kb_ + vlds[i_]) = VR_[i_]; } while (0)
    __syncthreads();
    ATTN_PF(0, kregA, vregA);
    ATTN_ST(0, kregA, vregA);
    if (a.nkt > 1) ATTN_PF(1, kregA, vregA);
    __syncthreads();
#define ATTN_ITER(kt) { \
        if ((kt) + 1 < a.nkt) ATTN_ST(((kt) + 1) & 1, kregA, vregA); \
        if ((kt) + 2 < a.nkt) ATTN_PF((kt) + 2, kregA, vregA); \
        attn_tile((kt)); \
        __syncthreads(); }
    auto attn_tile = [&](int kt) {
        const int hc = n64 - 2 * kt;
        if (hc > 0) {
            const char* Ks = smem + (kt & 1) * BUFB;
            const char* Vs = Ks + KBYTES;
            f32x4 st[2][8];
            __builtin_amdgcn_s_setprio(1);
#pragma unroll
            for (int nt = 0; nt < 8; ++nt) {
                if (nt < 4 || hc >= 2) {
                    st[0][nt] = (f32x4){0.f, 0.f, 0.f, 0.f}; st[1][nt] = (f32x4){0.f, 0.f, 0.f, 0.f};
#pragma unroll
                    for (int ks = 0; ks < KS; ++ks) {
                        const bf16x8 kf = *(const bf16x8*)(Ks + (nt * 16 + lr) * KROWB + (ks * 4 + lq) * 16);
                        st[0][nt] = __builtin_amdgcn_mfma_f32_16x16x32_bf16(kf, qf[0][ks], st[0][nt], 0, 0, 0);
                        st[1][nt] = __builtin_amdgcn_mfma_f32_16x16x32_bf16(kf, qf[1][ks], st[1][nt], 0, 0, 0);
                    }
                } else {
                    st[0][nt] = (f32x4){-1e30f, -1e30f, -1e30f, -1e30f}; st[1][nt] = st[0][nt];
                }
            }
            __builtin_amdgcn_s_setprio(0);
#pragma unroll
            for (int qt = 0; qt < 2; ++qt) {
                if (slope2 != 0.f) {
                    const int qd = wh * 32 + qt * 16 + lr + dist0 - kt * 128 - lq * 4;
#pragma unroll
                    for (int nt = 0; nt < 8; ++nt)
#pragma unroll
                        for (int jj = 0; jj < 4; ++jj) st[qt][nt][jj] -= slope2 * fabsf((float)(qd - nt * 16 - jj));
                }
                float mxa = max3f(st[qt][0][0], st[qt][0][1], st[qt][0][2]), mxb = max3f(st[qt][0][3], st[qt][1][0], st[qt][1][1]);
                mxa = max3f(mxa, st[qt][1][2], st[qt][1][3]);
#pragma unroll
                for (int nt = 2; nt < 8; nt += 2) {
                    mxb = max3f(mxb, st[qt][nt][0], st[qt][nt][1]); mxa = max3f(mxa, st[qt][nt][2], st[qt][nt][3]);
                    mxb = max3f(mxb, st[qt][nt + 1][0], st[qt][nt + 1][1]); mxa = max3f(mxa, st[qt][nt + 1][2], st[qt][nt + 1][3]);
                }
                float mx = fmaxf(mxa, mxb);
                mx = fmaxf(mx, __shfl_xor(mx, 16)); mx = fmaxf(mx, __shfl_xor(mx, 32));
                const float mnew = fmaxf(m[qt], mx);
                const float alpha = __builtin_amdgcn_exp2f(m[qt] - mnew);
                m[qt] = mnew;
                f32x4 rs4 = {0.f, 0.f, 0.f, 0.f};
                const f32x4 negm4 = {-mnew, -mnew, -mnew, -mnew};
#pragma unroll
                for (int nt = 0; nt < 8; ++nt) {
                    const f32x4 d4 = st[qt][nt] + negm4;
                    f32x4 e4;
                    e4[0] = __builtin_amdgcn_exp2f(d4[0]); e4[1] = __builtin_amdgcn_exp2f(d4[1]); e4[2] = __builtin_amdgcn_exp2f(d4[2]); e4[3] = __builtin_amdgcn_exp2f(d4[3]);
                    st[qt][nt] = e4; rs4 += e4;
                }
                float rs = (rs4[0] + rs4[1]) + (rs4[2] + rs4[3]);
                rs += __shfl_xor(rs, 16); rs += __shfl_xor(rs, 32);
                l[qt] = l[qt] * alpha + rs;
                if (__builtin_amdgcn_ballot_w64(alpha != 1.0f) != 0ull) {
#pragma unroll
                    for (int dt = 0; dt < 4; ++dt) ot[qt][dt] *= alpha;
                }
            }
            __builtin_amdgcn_s_setprio(1);
#pragma unroll
            for (int k2 = 0; k2 < 4; ++k2) {
                if (k2 < 2 || hc >= 2) {
                    bf16x8 pf[2];
#pragma unroll
                    for (int qt = 0; qt < 2; ++qt) {
                        const f32x8 p8 = __builtin_shufflevector(st[qt][2 * k2], st[qt][2 * k2 + 1], 0, 1, 2, 3, 4, 5, 6, 7);
                        pf[qt] = __builtin_bit_cast(bf16x8, __builtin_convertvector(p8, bf16v8_t));
                    }
#pragma unroll
                    for (int dt = 0; dt < 4; ++dt) {
                        const char* vrow = Vs + (dt * 16 + lr) * VROWB + lq * 8;
                        const uint2 v0 = *(const uint2*)(vrow + (2 * k2) * 32), v1 = *(const uint2*)(vrow + (2 * k2 + 1) * 32);
                        u32x4 vw; vw.x = v0.x; vw.y = v0.y; vw.z = v1.x; vw.w = v1.y;
                        const bf16x8 vf = __builtin_bit_cast(bf16x8, vw);
                        ot[0][dt] = __builtin_amdgcn_mfma_f32_16x16x32_bf16(vf, pf[0], ot[0][dt], 0, 0, 0);
                        ot[1][dt] = __builtin_amdgcn_mfma_f32_16x16x32_bf16(vf, pf[1], ot[1][dt], 0, 0, 0);
                    }
                }
            }
            __builtin_amdgcn_s_setprio(0);
        }
    };
    for (int kt = 0; kt < a.nkt; ++kt) ATTN_ITER(kt)
    if (active) {
#pragma unroll
        for (int qt = 0; qt < 2; ++qt) {
            const float inv = 1.0f / l[qt];
            bf16_t* orow = gw.o + g * gw.og + (long)(wh * 32 + qt * 16 + lr) * a.ldo + lq * 4;
#pragma unroll
            for (int dt = 0; dt < 4; ++dt) {
                uint2 w; w.x = pack2(ot[qt][dt][0] * inv, ot[qt][dt][1] * inv); w.y = pack2(ot[qt][dt][2] * inv, ot[qt][dt][3] * inv);
                *(uint2*)(orow + dt * 16) = w;
            }
        }
    }
}

__device__ __forceinline__ void mla_item(PP p, int item, char* smem) {
    AttnKV a; AttnW w;
    const bf16_t* Q = (const bf16_t*)(p->ws + B_Q);
    const bf16_t* KN = (const bf16_t*)(p->ws + C_KN);
    const bf16_t* KR = (const bf16_t*)(p->ws + A_KR);
    const bf16_t* VT = (const bf16_t*)(p->ws + C_VT);
    bf16_t* MIX = (bf16_t*)(p->ws + WS_H);
    long row0, key0; int hd, nkt;
    w.dist0 = 0; w.sinkp = nullptr; w.hq0 = 0;
    if (item >= 1024) {
        const int si = item - 1024; const int sb = si >> 3; hd = si & 7; row0 = MP + sb * 64; key0 = MP + (long)sb * 4160; nkt = 33;
        w.n64b = 65; w.n64s = 0; w.ngrp = 1;
    } else {
        const int it = item; const int cq = 63 - (it >> 4); const int b = (it >> 3) & 1; hd = it & 7;
        row0 = (long)b * 16384 + cq * 256; key0 = (long)b * 16384; nkt = 2 * cq + 2;
        w.n64b = 4 * cq + 1; w.n64s = 1; w.ngrp = 4;
    }
    w.q1 = Q + row0 * 768 + hd * 64; w.q2 = Q + row0 * 768 + 512 + hd * 32; w.o = MIX + row0 * 1024 + hd * 64;
    w.qg = 64 * 768; w.og = 64 * 1024;
    a.ldq = 768; a.ldo = 1024;
    a.k1 = KN + key0 * 512 + hd * 64; a.ldk1 = 512; a.k2 = KR + key0 * 32; a.ldk2 = 32;
    a.vt = VT + (long)(hd * 64) * KROWS + key0; a.ldvt = KROWS;
    a.nkt = nkt; a.has_sink = 0;
    attn_block<96>(a, w, smem);
}
__device__ __forceinline__ void swa_item(PP p, int jl, int item, char* smem) {
    AttnKV a; AttnW w;
    const bf16_t* Q = (const bf16_t*)(p->ws + B_Q);
    const bf16_t* SK = (const bf16_t*)(p->ws + B_SWK);
    const bf16_t* SVT = (const bf16_t*)(p->ws + B_SWVT);
    bf16_t* MIX = (bf16_t*)(p->ws + WS_H);
    long row0, key0; int kvh, nkt, dist0;
    if (item < 2048) { const int b = item >> 10; const int c = (item >> 2) & 255; kvh = item & 3; const int ks = (c >= 2 ? c - 2 : 0); row0 = (long)b * 16384 + c * 64; key0 = (long)b * 16384 + ks * 64; nkt = c + 1 - ks; dist0 = (c - ks) * 64; }
    else { const int it = item - 2048; const int sb = it >> 2; kvh = it & 3; row0 = MP + sb * 64; key0 = MP + (long)sb * 192; nkt = 3; dist0 = 128; }
    const int hq0 = kvh * 4;
    w.q1 = Q + row0 * 1024 + hq0 * 64; w.q2 = nullptr; w.o = MIX + row0 * 1024 + hq0 * 64;
    w.qg = 64; w.og = 64; w.dist0 = dist0;
    w.n64b = nkt; w.n64s = 0; w.ngrp = 4; w.sinkp = p->in[35] + jl * 16 + hq0; w.hq0 = hq0;
    a.ldq = 1024; a.ldo = 1024;
    a.k1 = SK + key0 * 256 + kvh * 64; a.ldk1 = 256; a.k2 = nullptr; a.ldk2 = 0;
    a.vt = SVT + (long)(kvh * 64) * SROWS + key0; a.ldvt = SROWS;
    a.nkt = (nkt + 1) >> 1; a.has_sink = 1;
    attn_block<64>(a, w, smem);
}

__device__ __forceinline__ void scan_task(PP p, int jl, int task, float* wl) {
    const int lane = TIDX & 63;
    const bool isPt = (task >= 2048 && task < 4096);
    const bool isS = task >= 4096;
    int hd, row0, nsteps, sb = 0, ctask = 0;
    if (!isS) { ctask = task & 2047; const int sh = ctask >> 7, c = ctask & 127; const int b = sh >> 3; hd = sh & 7; row0 = b * 16384 + c * 128; nsteps = 128; }
    else { const int t2 = task - 4096; sb = t2 >> 3; hd = t2 & 7; row0 = MP + sb * 64; nsteps = 64; }
    f32x2 U[32];
    if (isS) {
        const float* s0 = p->in[4] + ((long)(jl * 16 + sb) * 8 + hd) * 4096 + lane * 64;
#pragma unroll
        for (int jj = 0; jj < 32; ++jj) U[jj] = *(const f32x2*)(s0 + 2 * jj);
    } else if (isPt) {
#pragma unroll
        for (int jj = 0; jj < 32; ++jj) U[jj] = (f32x2){(2 * jj == lane) ? 1.f : 0.f, (2 * jj + 1 == lane) ? 1.f : 0.f};
    } else {
#pragma unroll
        for (int jj = 0; jj < 32; ++jj) U[jj] = (f32x2){0.f, 0.f};
    }
    const int col = hd * 64 + lane;
    const float kkw = p->in[27][jl * 512 + col], kaw = p->in[28][jl * 512 + col];
    const bf16_t* E = (const bf16_t*)(p->ws + B_E);
    const bf16_t* AA = (const bf16_t*)(p->ws + B_AA);
    const bf16_t* R = (const bf16_t*)(p->ws + A_R);
    const bf16_t* Kb = (const bf16_t*)(p->ws + A_K);
    const bf16_t* Vb = (const bf16_t*)(p->ws + A_V);
    bf16_t* MIX = (bf16_t*)(p->ws + WS_H);
    bf16_t* QT = (bf16_t*)(p->ws + A_QT);
    const float vmul = isPt ? 0.f : 1.f;
    bf16_t ne[4], na[4], nk[4], nr[4], nv[4];
#define SCANT_LOAD(T0) { _Pragma("unroll") for (int st = 0; st < 4; ++st) { const long idx = (long)(row0 + (T0) + st) * 512 + col; \
        ne[st] = E[idx]; na[st] = AA[idx]; nk[st] = Kb[idx]; nr[st] = R[idx]; nv[st] = Vb[idx]; } }
    SCANT_LOAD(0)
    for (int t0 = 0; t0 < nsteps; t0 += 4) {
        {
            float e_[4], a_[4], k_[4], r_[4], v_[4], ss[4];
#pragma unroll
            for (int st = 0; st < 4; ++st) {
                e_[st] = bf2f(ne[st]); a_[st] = bf2f(na[st]); k_[st] = bf2f(nk[st]); r_[st] = bf2f(nr[st]); v_[st] = bf2f(nv[st]);
                const float kkv = k_[st] * kkw; ss[st] = kkv * kkv;
            }
            if (t0 + 4 < nsteps) SCANT_LOAD(t0 + 4)
#pragma unroll
            for (int o = 32; o >= 1; o >>= 1) {
                float t_[4];
#pragma unroll
                for (int st = 0; st < 4; ++st) t_[st] = __shfl_xor(ss[st], o);
#pragma unroll
                for (int st = 0; st < 4; ++st) ss[st] += t_[st];
            }
#pragma unroll
            for (int st = 0; st < 4; ++st) {
                const float kkn = k_[st] * kkw * __builtin_amdgcn_rsqf(fmaxf(ss[st], 1e-24f));
                float* q = wl + st * 384;
                q[lane] = __expf(-e_[st]);
                q[64 + lane] = -kkn;
                q[128 + lane] = kkn * a_[st];
                q[192 + lane] = k_[st] * (1.f + (a_[st] - 1.f) * kaw);
                q[256 + lane] = r_[st];
                q[320 + lane] = v_[st] * vmul;
            }
        }
        WAVE_SYNC();
#pragma unroll 1
        for (int st = 0; st < 4; ++st) {
            const float* q = wl + st * 384;
            const float vi = q[320 + lane];
            const f32x4* Wq = (const f32x4*)q;
            const long orow = (long)(row0 + t0 + st);
            f32x2 sa0 = {0.f, 0.f}, sa1 = {0.f, 0.f};
#pragma unroll
            for (int h = 0; h < 2; ++h) {
                f32x4 t[8];
#pragma unroll
                for (int i = 0; i < 8; ++i) t[i] = Wq[16 + h * 8 + i];
#pragma unroll
                for (int i = 0; i < 8; ++i) { sa0 += U[h * 16 + 2 * i] * t[i].xy; sa1 += U[h * 16 + 2 * i + 1] * t[i].zw; }
            }
            const float sa = (sa0.x + sa0.y) + (sa1.x + sa1.y);
            f32x2 y0 = {0.f, 0.f}, y1 = {0.f, 0.f};
#pragma unroll
            for (int qd = 0; qd < 4; ++qd) {
                f32x4 tw[4], tb[4], tk[4], tr[4];
#pragma unroll
                for (int i = 0; i < 4; ++i) { tw[i] = Wq[qd * 4 + i]; tb[i] = Wq[32 + qd * 4 + i]; tk[i] = Wq[48 + qd * 4 + i]; tr[i] = Wq[64 + qd * 4 + i]; }
#pragma unroll
                for (int i = 0; i < 4; ++i) {
                    const int jj = qd * 8 + 2 * i;
                    U[jj] = U[jj] * tw[i].xy + (tb[i].xy * sa + tk[i].xy * vi);
                    U[jj + 1] = U[jj + 1] * tw[i].zw + (tb[i].zw * sa + tk[i].zw * vi);
                    y0 += U[jj] * tr[i].xy; y1 += U[jj + 1] * tr[i].zw;
                }
            }
            const bf16_t yo = f2bf((y0.x + y0.y) + (y1.x + y1.y));
            if (isPt) QT[orow * 512 + col] = yo;
            else MIX[orow * 1024 + 512 + col] = yo;
        }
        WAVE_SYNC();
    }
    if (isS) {
        float* So = p->out + O_SRW + ((long)(jl * 16 + sb) * 8 + hd) * 4096 + lane * 64;
#pragma unroll
        for (int jj = 0; jj < 32; ++jj) *(f32x2*)(So + 2 * jj) = U[jj];
    } else if (isPt) {
        bf16_t* Pb = (bf16_t*)(p->ws + B_PB) + (long)ctask * 4096 + lane * 64;
#pragma unroll
        for (int jj = 0; jj < 32; ++jj) *(uint32_t*)(Pb + 2 * jj) = pack2(U[jj].x, U[jj].y);
    } else {
        float* Ub = (float*)(p->ws + A_U) + (long)ctask * 4096 + lane * 64;
#pragma unroll
        for (int jj = 0; jj < 32; ++jj) *(f32x2*)(Ub + 2 * jj) = U[jj];
    }
}
__device__ __forceinline__ void scan_fused(PP p, int jl, int ctask, float* wl) {
    const int lane = TIDX & 63;
    const int sh = ctask >> 7, c = ctask & 127, b = sh >> 3, hd = sh & 7;
    const int row0 = b * 16384 + c * 128;
    f32x2 U[32], Pm[32];
#pragma unroll
    for (int jj = 0; jj < 32; ++jj) { U[jj] = (f32x2){0.f, 0.f}; Pm[jj] = (f32x2){(2 * jj == lane) ? 1.f : 0.f, (2 * jj + 1 == lane) ? 1.f : 0.f}; }
    const int col = hd * 64 + lane;
    const float kkw = p->in[27][jl * 512 + col], kaw = p->in[28][jl * 512 + col];
    const bf16_t* E = (const bf16_t*)(p->ws + B_E);
    const bf16_t* AA = (const bf16_t*)(p->ws + B_AA);
    const bf16_t* R = (const bf16_t*)(p->ws + A_R);
    const bf16_t* Kb = (const bf16_t*)(p->ws + A_K);
    const bf16_t* Vb = (const bf16_t*)(p->ws + A_V);
    bf16_t* MIX = (bf16_t*)(p->ws + WS_H);
    bf16_t* QT = (bf16_t*)(p->ws + A_QT);
    bf16_t ne[4], na[4], nk[4], nr[4], nv[4];
#define SCAN_LOAD(T0) { _Pragma("unroll") for (int st = 0; st < 4; ++st) { const long idx = (long)(row0 + (T0) + st) * 512 + col; \
        ne[st] = E[idx]; na[st] = AA[idx]; nk[st] = Kb[idx]; nr[st] = R[idx]; nv[st] = Vb[idx]; } }
    SCAN_LOAD(0)
    for (int t0 = 0; t0 < 128; t0 += 4) {
        {
            float e_[4], a_[4], k_[4], r_[4], v_[4], ss[4];
#pragma unroll
            for (int st = 0; st < 4; ++st) {
                e_[st] = bf2f(ne[st]); a_[st] = bf2f(na[st]); k_[st] = bf2f(nk[st]); r_[st] = bf2f(nr[st]); v_[st] = bf2f(nv[st]);
                const float kkv = k_[st] * kkw; ss[st] = kkv * kkv;
            }
            if (t0 + 4 < 128) SCAN_LOAD(t0 + 4)
#pragma unroll
            for (int o = 32; o >= 1; o >>= 1) {
                float t_[4];
#pragma unroll
                for (int st = 0; st < 4; ++st) t_[st] = __shfl_xor(ss[st], o);
#pragma unroll
                for (int st = 0; st < 4; ++st) ss[st] += t_[st];
            }
#pragma unroll
            for (int st = 0; st < 4; ++st) {
                const float kkn = k_[st] * kkw * __builtin_amdgcn_rsqf(fmaxf(ss[st], 1e-24f));
                float* q = wl + st * 384;
                q[lane] = __expf(-e_[st]);
                q[64 + lane] = -kkn;
                q[128 + lane] = kkn * a_[st];
                q[192 + lane] = k_[st] * (1.f + (a_[st] - 1.f) * kaw);
                q[256 + lane] = r_[st];
                q[320 + lane] = v_[st];
            }
        }
        WAVE_SYNC();
#pragma unroll 1
        for (int st = 0; st < 4; ++st) {
            const float* q = wl + st * 384;
            const float vi = q[320 + lane];
            const f32x4* Wq = (const f32x4*)q;
            const long orow = (long)(row0 + t0 + st);
            f32x2 sa0 = {0.f, 0.f}, sa1 = {0.f, 0.f}, sp0 = {0.f, 0.f}, sp1 = {0.f, 0.f};
#pragma unroll
            for (int h = 0; h < 2; ++h) {
                f32x4 t[8];
#pragma unroll
                for (int i = 0; i < 8; ++i) t[i] = Wq[16 + h * 8 + i];
#pragma unroll
                for (int i = 0; i < 8; ++i) {
                    sa0 += U[h * 16 + 2 * i] * t[i].xy; sa1 += U[h * 16 + 2 * i + 1] * t[i].zw;
                    sp0 += Pm[h * 16 + 2 * i] * t[i].xy; sp1 += Pm[h * 16 + 2 * i + 1] * t[i].zw;
                }
            }
            const float sa = (sa0.x + sa0.y) + (sa1.x + sa1.y), sp = (sp0.x + sp0.y) + (sp1.x + sp1.y);
            f32x2 y0 = {0.f, 0.f}, y1 = {0.f, 0.f}, z0 = {0.f, 0.f}, z1 = {0.f, 0.f};
#pragma unroll
            for (int qd = 0; qd < 8; ++qd) {
                f32x4 tw[2], tb[2], tk[2], tr[2];
#pragma unroll
                for (int i = 0; i < 2; ++i) { tw[i] = Wq[qd * 2 + i]; tb[i] = Wq[32 + qd * 2 + i]; tk[i] = Wq[48 + qd * 2 + i]; tr[i] = Wq[64 + qd * 2 + i]; }
#pragma unroll
                for (int i = 0; i < 2; ++i) {
                    const int jj = qd * 4 + 2 * i;
                    U[jj] = U[jj] * tw[i].xy + (tb[i].xy * sa + tk[i].xy * vi);
                    U[jj + 1] = U[jj + 1] * tw[i].zw + (tb[i].zw * sa + tk[i].zw * vi);
                    Pm[jj] = Pm[jj] * tw[i].xy + tb[i].xy * sp;
                    Pm[jj + 1] = Pm[jj + 1] * tw[i].zw + tb[i].zw * sp;
                    y0 += U[jj] * tr[i].xy; y1 += U[jj + 1] * tr[i].zw;
                    z0 += Pm[jj] * tr[i].xy; z1 += Pm[jj + 1] * tr[i].zw;
                }
            }
            MIX[orow * 1024 + 512 + col] = f2bf((y0.x + y0.y) + (y1.x + y1.y));
            QT[orow * 512 + col] = f2bf((z0.x + z0.y) + (z1.x + z1.y));
        }
        WAVE_SYNC();
    }
    float* Ub = (float*)(p->ws + A_U) + (long)ctask * 4096 + lane * 64;
    bf16_t* Pb = (bf16_t*)(p->ws + B_PB) + (long)ctask * 4096 + lane * 64;
#pragma unroll
    for (int jj = 0; jj < 32; ++jj) { *(f32x2*)(Ub + 2 * jj) = U[jj]; *(uint32_t*)(Pb + 2 * jj) = pack2(Pm[jj].x, Pm[jj].y); }
}
__device__ __forceinline__ void chain_item(PP p, int jl, int sh, char* smem) {
    const int tid = TIDX, i = tid >> 3, jq = tid & 7;
    float* Sl = (float*)smem;
    float* Pl = (float*)(smem + 16640);
    float acc[8];
    __syncthreads();
#pragma unroll
    for (int jj = 0; jj < 8; ++jj) Sl[i * 65 + jq * 8 + jj] = 0.f;
    const bf16_t* Pb0 = (const bf16_t*)(p->ws + B_PB) + (long)sh * 128 * 4096 + tid * 8;
    float* Ub0 = (float*)(p->ws + A_U) + (long)sh * 128 * 4096 + i * 64 + jq * 8;
    u32x4 pn = *(const u32x4*)Pb0;
    f32x4 un0 = *(const f32x4*)Ub0, un1 = *(const f32x4*)(Ub0 + 4);
    for (int c = 0; c < 128; ++c) {
        const u32x4 pc = pn; const f32x4 uc0 = un0, uc1 = un1;
        __syncthreads();
        {
            float* d = Pl + tid * 8;
            *(f32x4*)d = (f32x4){bf2f(pc.x & 0xffff), bf2f(pc.x >> 16), bf2f(pc.y & 0xffff), bf2f(pc.y >> 16)};
            *(f32x4*)(d + 4) = (f32x4){bf2f(pc.z & 0xffff), bf2f(pc.z >> 16), bf2f(pc.w & 0xffff), bf2f(pc.w >> 16)};
        }
        if (c + 1 < 128) { pn = *(const u32x4*)(Pb0 + (long)(c + 1) * 4096); un0 = *(const f32x4*)(Ub0 + (long)(c + 1) * 4096); un1 = *(const f32x4*)(Ub0 + (long)(c + 1) * 4096 + 4); }
        acc[0] = uc0.x; acc[1] = uc0.y; acc[2] = uc0.z; acc[3] = uc0.w; acc[4] = uc1.x; acc[5] = uc1.y; acc[6] = uc1.z; acc[7] = uc1.w;
        __syncthreads();
#pragma unroll 8
        for (int j0 = 0; j0 < 64; ++j0) {
            const float sv = Sl[i * 65 + j0];
            const f32x4 v0 = *(const f32x4*)(Pl + j0 * 64 + jq * 8), v1 = *(const f32x4*)(Pl + j0 * 64 + jq * 8 + 4);
            acc[0] += sv * v0.x; acc[1] += sv * v0.y; acc[2] += sv * v0.z; acc[3] += sv * v0.w;
            acc[4] += sv * v1.x; acc[5] += sv * v1.y; acc[6] += sv * v1.z; acc[7] += sv * v1.w;
        }
        __syncthreads();
#pragma unroll
        for (int jj = 0; jj < 8; ++jj) Sl[i * 65 + jq * 8 + jj] = acc[jj];
        float* Ub = Ub0 + (long)c * 4096;
        *(f32x4*)Ub = (f32x4){acc[0], acc[1], acc[2], acc[3]};
        *(f32x4*)(Ub + 4) = (f32x4){acc[4], acc[5], acc[6], acc[7]};
    }
    const int b = sh >> 3, hd = sh & 7;
    float* So = p->out + O_PRW + ((long)(jl * 2 + b) * 8 + hd) * 4096 + i * 64 + jq * 8;
    *(f32x4*)So = (f32x4){acc[0], acc[1], acc[2], acc[3]};
    *(f32x4*)(So + 4) = (f32x4){acc[4], acc[5], acc[6], acc[7]};
    __syncthreads();
}
__device__ __forceinline__ void fin_task(PP p, int jl, int task, float* wl) {
    const int lane = TIDX & 63;
    const bool isP = task < 2048;
    int hd, row0, nsteps, c = 0;
    if (isP) { const int sh = task >> 7; c = task & 127; const int b = sh >> 3; hd = sh & 7; row0 = b * 16384 + c * 128; nsteps = 128; }
    else { const int t2 = task - 2048; const int sb = t2 >> 3; hd = t2 & 7; row0 = MP + sb * 64; nsteps = 64; }
    const bool corr = isP && c > 0;
    f32x2 S[32];
    if (corr) {
        const float* Ub = (const float*)(p->ws + A_U) + (long)(task - 1) * 4096 + lane * 64;
#pragma unroll
        for (int jj = 0; jj < 32; ++jj) S[jj] = *(const f32x2*)(Ub + 2 * jj);
    } else {
#pragma unroll
        for (int jj = 0; jj < 32; ++jj) S[jj] = (f32x2){0.f, 0.f};
    }
    const int col = hd * 64 + lane;
    const float kaw = p->in[28][jl * 512 + col], rk = p->in[29][jl * 512 + col], lw = p->in[30][jl * 512 + col], lb = p->in[31][jl * 512 + col];
    const bf16_t* AA = (const bf16_t*)(p->ws + B_AA);
    const bf16_t* G = (const bf16_t*)(p->ws + B_G);
    const bf16_t* R = (const bf16_t*)(p->ws + A_R);
    const bf16_t* Kb = (const bf16_t*)(p->ws + A_K);
    const bf16_t* Vb = (const bf16_t*)(p->ws + A_V);
    bf16_t* MIX = (bf16_t*)(p->ws + WS_H);
    const bf16_t* QT = (const bf16_t*)(p->ws + A_QT);
    bf16_t ny[4], nr[4], nk[4], na[4], nv[4], ng[4], nq[4];
#define FIN_LOAD(T0) { _Pragma("unroll") for (int st = 0; st < 4; ++st) { const long row = row0 + (T0) + st; const long idx = row * 512 + col; \
        ny[st] = MIX[row * 1024 + 512 + col]; nr[st] = R[idx]; nk[st] = Kb[idx]; na[st] = AA[idx]; nv[st] = Vb[idx]; ng[st] = G[idx]; nq[st] = corr ? QT[idx] : (bf16_t)0; } }
    FIN_LOAD(0)
    for (int t0 = 0; t0 < nsteps; t0 += 4) {
        float yv[4], rv[4], kv[4], av[4], vv[4], gv[4];
#pragma unroll
        for (int st = 0; st < 4; ++st) {
            yv[st] = bf2f(ny[st]); rv[st] = bf2f(nr[st]); kv[st] = bf2f(nk[st]); av[st] = bf2f(na[st]); vv[st] = bf2f(nv[st]); gv[st] = bf2f(ng[st]);
            if (corr) wl[st * 64 + lane] = bf2f(nq[st]);
        }
        if (t0 + 4 < nsteps) FIN_LOAD(t0 + 4)
        WAVE_SYNC();
        if (corr) {
#pragma unroll
            for (int st = 0; st < 4; ++st) {
                const f32x4* q4 = (const f32x4*)(wl + st * 64);
                f32x2 c0 = {0.f, 0.f}, c1 = {0.f, 0.f};
#pragma unroll
                for (int h = 0; h < 2; ++h) {
                    f32x4 t[8];
#pragma unroll
                    for (int i = 0; i < 8; ++i) t[i] = q4[h * 8 + i];
#pragma unroll
                    for (int i = 0; i < 8; ++i) { c0 += S[h * 16 + 2 * i] * t[i].xy; c1 += S[h * 16 + 2 * i + 1] * t[i].zw; }
                }
                yv[st] += (c0.x + c0.y) + (c1.x + c1.y);
            }
        }
        float r0[4], r1[4], r2[4];
#pragma unroll
        for (int st = 0; st < 4; ++st) { r0[st] = yv[st]; r1[st] = yv[st] * yv[st]; r2[st] = rv[st] * (kv[st] * (1.f + (av[st] - 1.f) * kaw)) * rk; }
#pragma unroll
        for (int o = 32; o >= 1; o >>= 1) {
            float t0_[4], t1_[4], t2_[4];
#pragma unroll
            for (int st = 0; st < 4; ++st) { t0_[st] = __shfl_xor(r0[st], o); t1_[st] = __shfl_xor(r1[st], o); t2_[st] = __shfl_xor(r2[st], o); }
#pragma unroll
            for (int st = 0; st < 4; ++st) { r0[st] += t0_[st]; r1[st] += t1_[st]; r2[st] += t2_[st]; }
        }
#pragma unroll
        for (int st = 0; st < 4; ++st) {
            const long row = row0 + t0 + st;
            const float mu = r0[st] * (1.0f / 64.0f);
            const float var = fmaxf(r1[st] * (1.0f / 64.0f) - mu * mu, 0.f);
            const float yn = (yv[st] - mu) * rsqrtf(var + 64e-5f) * lw + lb;
            MIX[row * 1024 + 512 + col] = f2bf((yn + r2[st] * vv[st]) * gv[st]);
        }
        WAVE_SYNC();
    }
}


#define XB_TMO      128
#define XB_XCNT(j)  (256  + 64 * (j))
#define XB_XSUB(j)  (1280 + 64 * (j))
#define XB_XGEN(j)  (2304 + 64 * (j))
#define XB_TOP      3328
#define XB_TOPGEN   3392
#define XCD_BAR_WORDS 3456
#define XB_SPIN_CAP (1u << 28)
__device__ __forceinline__ unsigned xb_ld(unsigned* p)              { return __hip_atomic_load(p, __ATOMIC_RELAXED, __HIP_MEMORY_SCOPE_AGENT); }
__device__ __forceinline__ unsigned xb_add(unsigned* p, unsigned v) { return __hip_atomic_fetch_add(p, v, __ATOMIC_RELAXED, __HIP_MEMORY_SCOPE_AGENT); }
__device__ __forceinline__ unsigned xb_xcc_id() { return (unsigned)__builtin_amdgcn_s_getreg((3 << 11) | 20) & 0xFu; }
#define XB_SPIN(cond, bar) do { unsigned _sp = 0; while (cond) { __builtin_amdgcn_s_sleep(1); \
    if ((++_sp & 255u) == 0u) { if (xb_ld(&(bar)[XB_TMO])) break; if (_sp > XB_SPIN_CAP) { atomicAdd(&(bar)[XB_TMO], 1u); break; } } } } while (0)
struct XcdBarrier { unsigned* bar; unsigned x; volatile LAS unsigned* st; };
__device__ __forceinline__ XcdBarrier xcd_barrier_post(unsigned* bar, volatile LAS unsigned* st) {
    XcdBarrier b; b.bar = bar; b.x = xb_xcc_id(); b.st = st;
    if (threadIdx.x == 0) (void)xb_add(&bar[XB_XCNT(b.x)], 1u);
    return b;
}
__device__ __forceinline__ void xcd_barrier_complete(unsigned* bar, unsigned x, unsigned& nloc, unsigned& nx) {
    const unsigned G = gridDim.x * gridDim.y * gridDim.z;
    unsigned sum, cnt, mine, sp = 0u;
    for (;;) {
        sum = 0u; cnt = 0u; mine = 0u;
#pragma unroll
        for (unsigned j = 0; j < 16; ++j) { const unsigned c = xb_ld(&bar[XB_XCNT(j)]); sum += c; cnt += (c > 0u) ? 1u : 0u; mine = (j == x) ? c : mine; }
        if (sum == G) break;
        __builtin_amdgcn_s_sleep(1);
        if ((++sp & 255u) == 0u) { if (xb_ld(&bar[XB_TMO])) break; if (sp > XB_SPIN_CAP) { atomicAdd(&bar[XB_TMO], 1u); break; } }
    }
    nloc = mine > 0u ? mine : 1u; nx = cnt > 0u ? cnt : 1u;
}
__device__ __forceinline__ void xcd_barrier(const XcdBarrier& b) {
    asm volatile("s_waitcnt vmcnt(0)" ::: "memory");
    __syncthreads();
    if (threadIdx.x == 0) {
        unsigned* bar = b.bar;
        __builtin_amdgcn_s_waitcnt(0);
        unsigned nloc = b.st[0], nx = b.st[1];
        const unsigned old = xb_add(&bar[XB_XSUB(b.x)], 1u);
        const unsigned gen = old / nloc;
        if (old + 1u == (gen + 1u) * nloc) {
            __builtin_amdgcn_fence(__ATOMIC_RELEASE, "agent");
            asm volatile("s_waitcnt vmcnt(0)" ::: "memory");
            const unsigned og = xb_add(&bar[XB_TOP], 1u);
            const unsigned tg = og / nx;
            if (og + 1u == (tg + 1u) * nx) xb_add(&bar[XB_TOPGEN], 1u);
            else XB_SPIN(xb_ld(&bar[XB_TOPGEN]) == tg, bar);
            __builtin_amdgcn_fence(__ATOMIC_ACQUIRE, "agent");
            xb_add(&bar[XB_XGEN(b.x)], 1u);
            asm volatile("s_waitcnt vmcnt(0)" ::: "memory");
        } else {
            XB_SPIN(xb_ld(&bar[XB_XGEN(b.x)]) == gen, bar);
            __builtin_amdgcn_fence(__ATOMIC_ACQUIRE, "agent");
            asm volatile("s_waitcnt vmcnt(0)" ::: "memory");
        }
    }
    __syncthreads();
}

#define GSYNC() xcd_barrier(xb)
#ifndef DUP_FFNIN
#define DUP_FFNIN 0
#endif
#ifndef DUP_MLA
#define DUP_MLA 0
#endif
#ifndef DUP_SCAN
#define DUP_SCAN 0
#endif
#ifndef DUP_NORM
#define DUP_NORM 0
#endif
#ifndef DUP_MISC
#define DUP_MISC 0
#endif
#ifndef DUP_RESID
#define DUP_RESID 0
#endif
#ifndef DUP_ODD
#define DUP_ODD 0
#endif
#define LAUNDER(q) PP q = (PP)__builtin_amdgcn_kernarg_segment_ptr(); asm volatile("" : "+s"(q));

__global__ void __launch_bounds__(NTHR, 2) fwd_megakernel(Params p0) {
    cg::grid_group grid = cg::this_grid();
    __shared__ __attribute__((aligned(16))) char smem[SMEM_BYTES];
    __shared__ uint4 xb_words;
    const int G = gridDim.x, bid = blockIdx.x;
    if (threadIdx.x == 0) xb_words = make_uint4(0u, 0u, 0u, 0u);
    __syncthreads();
    XcdBarrier xb = xcd_barrier_post((unsigned*)p0.ws, (volatile LAS unsigned*)&xb_words);
    { LAUNDER(p) phase0(p, smem); }
    grid.sync();
    if (threadIdx.x == 0) { unsigned nloc, nx; xcd_barrier_complete(xb.bar, xb.x, nloc, nx); xb.st[0] = nloc; xb.st[1] = nx; }
    __syncthreads();
#pragma unroll 1
    for (int l = 0; l < 4; ++l) {
        const int jl = l >> 1;
        const bool odd = l & 1;
        {
            LAUNDER(p)
            const int wave = TIDX >> 6;
            conv_phase(p, l, bid, G, smem);
            norm_phase(p, l, 0, bid * 8 + wave, G * 8);
        }
        GSYNC();
#pragma unroll 1
        for (int f = 0; f < 2; ++f) {
            if (f == 1) {
                LAUNDER(p)
                const int wave = TIDX >> 6;
                norm_phase(p, l, 2, bid * 8 + wave, G * 8);
                GSYNC();
            }
            for (int rep = 0; rep <= DUP_FFNIN; ++rep) {
                LAUNDER(p)
                for (int T = bid; T < 132 * 22; T += G) { int pm, pn; tile_map256(T, 132, 22, pm, pn); t256_ffn_in(p, f, pm, pn, smem); }
                GSYNC();
            }
            for (int rep = 0; rep <= DUP_RESID; ++rep) {
                LAUNDER(p)
                for (int T = bid; T < 512 + 16 * 11; T += G) {
                    int pm, pn;
                    if (T < 512) {
                        tile_map256(T, 132, 4, pm, pn);
                        t256_resid(p, (const bf16_t*)(p->ws + WS_BIG), 2816, (const bf16_t*)(p->ws + W_FO) + (long)f * 1024 * 2816, 2816, l, f == 0 ? 2 : 8, rep ? 0.f : 0.5f, pm, pn, smem);
                    } else {
                        const int u = T - 512; tile_map256(512 + u / 11, 132, 4, pm, pn);
                        t256_resid(p, (const bf16_t*)(p->ws + WS_BIG), 2816, (const bf16_t*)(p->ws + W_FO) + (long)f * 1024 * 2816, 2816, l, f == 0 ? 2 : 8, rep ? 0.f : 0.5f, pm, pn, smem, (u % 11) * 256, 256, true);
                    }
                }
                GSYNC();
            }
            if (f == 1) break;
            for (int rep = 0; rep <= DUP_NORM; ++rep) {
                LAUNDER(p)
                const int wave = TIDX >> 6;
                norm_phase(p, l, 1, bid * 8 + wave, G * 8);
                GSYNC();
            }
            if (!odd) {
                for (int rep = 0; rep <= DUP_MISC; ++rep) {
                    LAUNDER(p)
                    for (int T = bid; T < 132 * 12; T += G) { int pm, pn; tile_map256(T, 132, 12, pm, pn); t256_even_in(p, pm, pn, smem); }
                    GSYNC();
                }
                for (int rep = 0; rep <= DUP_MISC; ++rep) {
                    LAUNDER(p)
                    const int tid = TIDX, wave = tid >> 6;
                    for (int row = bid * 8 + wave; row < MT; row += G * 8) even_prep_row(p, jl, row);
                    const long gtid = (long)bid * NTHR + tid, gsz = (long)G * NTHR;
                    const float* cc = p->in[2] + (long)jl * 16 * 4096 * 256;
                    bf16_t* CK = (bf16_t*)(p->ws + A_CKV);
                    for (long i0 = gtid; i0 < 16L * 4096 * 64; i0 += 4 * gsz) {
                        f32x4 v4[4];
#pragma unroll
                        for (int u = 0; u < 4; ++u) v4[u] = *(const f32x4*)(cc + (i0 + u * gsz) * 4);
#pragma unroll
                        for (int u = 0; u < 4; ++u) {
                            const long e = (i0 + u * gsz) * 4; const int sb = (int)(e >> 20); const long rem = e & ((1 << 20) - 1);
                            uint2 w; w.x = pack2(v4[u].x, v4[u].y); w.y = pack2(v4[u].z, v4[u].w);
                            *(uint2*)(CK + ((long)MP + (long)sb * 4160) * 256 + rem) = w;
                        }
                    }
                    const float* kc = p->in[3] + (long)jl * 16 * 4096 * 32;
                    bf16_t* KR = (bf16_t*)(p->ws + A_KR);
                    for (long i = gtid; i < 16L * 4096 * 8; i += gsz) {
                        const long e = i * 4; const int sb = (int)(e >> 17); const long rem = e & ((1 << 17) - 1);
                        const float4 v = *(const float4*)(kc + e);
                        uint2 w; w.x = pack2(v.x, v.y); w.y = pack2(v.z, v.w);
                        *(uint2*)(KR + ((long)MP + (long)sb * 4160) * 32 + rem) = w;
                    }
                    GSYNC();
                }
                for (int rep = 0; rep <= DUP_MISC; ++rep) {
                    LAUNDER(p)
                    const int nq = 132 * 3, nl = 3 * 264 * 4 / 2;
                    for (int T = bid; T < nq + nl; T += G) {
                        if (T < nq) { int pm, pn; tile_map256(T, 132, 3, pm, pn); t256_qup(p, pm, pn, smem); }
                        else {
                            const int half = TIDX >> 8;
                            const int t2 = (T - nq) * 2 + half; const int which = t2 / (264 * 4);
                            int mt, nt; tile_map(t2 % (264 * 4), 264, 4, mt, nt);
                            tile_lora(p, jl, which, mt, nt, smem + half * HALF_LDS);
                        }
                    }
                    GSYNC();
                }
                for (int rep = 0; rep <= DUP_SCAN; ++rep) {
                    LAUNDER(p)
                    const int wave = TIDX >> 6;
                    float* wl = (float*)smem + wave * 1536;
                    const int nscan = 16 + 256;
                    for (int T = bid; T < nscan + 388 * 4; T += G) {
                        if (T < 16) { __syncthreads(); scan_task(p, jl, 4096 + T * 8 + wave, wl); __syncthreads(); }
                        else if (T < nscan) { __syncthreads(); scan_fused(p, jl, (T - 16) * 8 + wave, wl); __syncthreads(); }
                        else { int pm, pn; tile_map256(T - nscan, 388, 4, pm, pn); t256_kvup(p, pm, pn, smem); }
                    }
                    GSYNC();
                }
                _Pragma("unroll 1") for (int rep = 0; rep <= DUP_MLA; ++rep) {
                    LAUNDER(p)
                    for (int i = 0; i * G < 16 + 128 + 1024; ++i) {
                        const int T = i * G + ((i & 1) ? G - 1 - bid : bid);
                        if (T >= 16 + 128 + 1024) continue;
                        if (T < 16) { if (rep == 0) chain_item(p, jl, T, smem); }
                        else mla_item(p, T - 16, smem);
                    }
                    GSYNC();
                }
                {
                    LAUNDER(p)
                    const int wave = TIDX >> 6;
                    float* wl = (float*)smem + wave * 1536;
                    for (int T = bid; T < (2048 + 128) / 8; T += G) { __syncthreads(); fin_task(p, jl, T * 8 + wave, wl); __syncthreads(); }
                }
                GSYNC();
                {
                    LAUNDER(p)
                    for (int T = bid; T < 512 + 16 * 4; T += G) {
                        int pm, pn;
                        if (T < 512) { tile_map256(T, 132, 4, pm, pn); t256_resid(p, (const bf16_t*)(p->ws + WS_H), 1024, (const bf16_t*)(p->ws + W_EO), 1024, l, 5, 1.0f, pm, pn, smem); }
                        else { const int u = T - 512; tile_map256(512 + (u >> 2), 132, 4, pm, pn); t256_resid(p, (const bf16_t*)(p->ws + WS_H), 1024, (const bf16_t*)(p->ws + W_EO), 1024, l, 5, 1.0f, pm, pn, smem, (u & 3) * 256, 256, true); }
                    }
                }
                GSYNC();
            } else {
                for (int rep = 0; rep <= DUP_ODD; ++rep) {
                    LAUNDER(p)
                    for (int T = bid; T < 132 * 6; T += G) { int pm, pn; tile_map256(T, 132, 6, pm, pn); t256_oddqkv(p, jl, pm, pn, smem); }
                    const long gtid = (long)bid * NTHR + TIDX, gsz = (long)G * NTHR;
                    bf16_t* SK = (bf16_t*)(p->ws + B_SWK);
                    bf16_t* SVT = (bf16_t*)(p->ws + B_SWVT);
                    for (long i = gtid; i < 16L * 128 * 256; i += gsz) {
                        const int c = (int)(i & 255); const int r = (int)((i >> 8) & 127); const int sb = (int)(i >> 15);
                        const long src = ((long)(jl * 16 + sb) * 128 + r) * 256 + c;
                        const long keyrow = (long)MP + sb * 192 + r;
                        SK[keyrow * 256 + c] = f2bf(p->in[6][src]);
                        SVT[(long)c * SROWS + keyrow] = f2bf(p->in[7][src]);
                    }
                    GSYNC();
                }
                for (int rep = 0; rep <= DUP_ODD; ++rep) {
                    LAUNDER(p)
                    for (int T = bid; T < 2048 + 64; T += G) swa_item(p, jl, T, smem);
                    GSYNC();
                }
                {
                    LAUNDER(p)
                    for (int T = bid; T < 512 + 16 * 4; T += G) {
                        int pm, pn;
                        if (T < 512) { tile_map256(T, 132, 4, pm, pn); t256_resid(p, (const bf16_t*)(p->ws + WS_H), 1024, (const bf16_t*)(p->ws + W_OO), 1024, l, 5, 1.0f, pm, pn, smem); }
                        else { const int u = T - 512; tile_map256(512 + (u >> 2), 132, 4, pm, pn); t256_resid(p, (const bf16_t*)(p->ws + WS_H), 1024, (const bf16_t*)(p->ws + W_OO), 1024, l, 5, 1.0f, pm, pn, smem, (u & 3) * 256, 256, true); }
                    }
                }
                GSYNC();
            }
        }
    }
    {
        LAUNDER(p)
        const int wave = TIDX >> 6;
        for (int row = bid * 8 + wave; row < MT; row += G * 8) final_norm_row(p, row);
    }
}

extern "C" void kernel_launch(void* const* d_in, const int* in_sizes, int n_in, void* d_out, int out_size, void* d_ws, size_t ws_size,
                              hipStream_t stream) {
    static int grid_blocks = 0;
    if (!grid_blocks) {
        int dev = 0, cus = 0, per_cu = 0;
        hipGetDevice(&dev);
        hipDeviceGetAttribute(&cus, hipDeviceAttributeMultiprocessorCount, dev);
        hipOccupancyMaxActiveBlocksPerMultiprocessor(&per_cu, fwd_megakernel, NTHR, 0);
        per_cu = 1;
        grid_blocks = cus * per_cu;
    }
    Params p{};
    for (int i = 0; i < 37; ++i) p.in[i] = (const float*)d_in[i];
    p.out = (float*)d_out;
    p.ws = (char*)d_ws;
    void* args[] = {&p};
    (void)hipMemsetAsync(d_ws, 0, XCD_BAR_WORDS * 4, stream);
    hipError_t e = hipLaunchCooperativeKernel((void*)fwd_megakernel, dim3(grid_blocks), dim3(NTHR), args, 0, stream);
    if (e != hipSuccess) fprintf(stderr, "cooperative launch failed: %s (grid %d)\n", hipGetErrorString(e), grid_blocks);
}
```
